# Optimizing an MI355X kernel written in HIP

```python
import math
import jax, jax.numpy as jnp
from jax import lax
import numpy as np


D_MODEL = 1024
BATCH = 8
SEQ = 8192
DEPTH = 1
DEC_BATCH = 128
DEC_SEQ = 8
PAST_LEN = 8192
PAGE_SIZE = 128

N_HEADS = 8
HEAD_DIM = 64
D_ATTN = N_HEADS * HEAD_DIM
D_RNN = D_MODEL // 2
N_RNN_BLOCKS = 8
RNN_BLOCK = D_RNN // N_RNN_BLOCKS
CONV_WIDTH = 4
LRU_C = 8.0
D_MIX = D_ATTN + D_RNN
IN_COLS = 3 * D_ATTN + 2 * D_RNN
D_FF = ((8 * D_MODEL // 3 + 255) // 256) * 256
DILATED = ((128, 1), (512, 4), (2048, 16))
MAX_WINDOW = 2048
BLK = 128
EPS = 1e-6

kernel_name = 'dilated_swa_rglru_macaron_hybrid'


def rmsnorm(x, g):
    xf = x.astype(jnp.float32)
    y = xf * lax.rsqrt(jnp.mean(xf * xf, axis=-1, keepdims=True) + EPS)
    return (y * g.astype(jnp.float32)).astype(x.dtype)


def swiglu(x, wg, wu, wd):
    return (jax.nn.silu(x @ wg) * (x @ wu)) @ wd


def _fold(t, dil, sp):
    b, s = t.shape[:2]
    rest = t.shape[2:]
    t = jnp.pad(t, [(0, 0), (0, sp - s)] + [(0, 0)] * len(rest))
    t = jnp.moveaxis(t.reshape(b, sp // dil, dil, *rest), 2, 1)
    return t.reshape(b, dil, sp // (dil * BLK), BLK, *rest)


def _unfold(t, s):
    b, dil, nb, blk = t.shape[:4]
    rest = t.shape[4:]
    t = jnp.moveaxis(t.reshape(b, dil, nb * blk, *rest), 1, 2)
    return t.reshape(b, dil * nb * blk, *rest)[:, :s]


def branch_prompt(q, k, v, win, dil):
    b, s, h, c = q.shape
    span = dil * BLK
    sp = -(-s // span) * span
    nb = sp // span
    qb, kb, vb = _fold(q, dil, sp), _fold(k, dil, sp), _fold(v, dil, sp)

    def with_prev(t):
        prev = jnp.pad(t[:, :, :-1], ((0, 0), (0, 0), (1, 0), (0, 0), (0, 0), (0, 0)))
        return jnp.concatenate([prev, t], axis=3)

    kk, vv = with_prev(kb), with_prev(vb)
    sc = jnp.einsum('bgnqhc,bgnkhc->bgnhqk', qb, kk, preferred_element_type=jnp.float32)
    qi = jnp.arange(BLK)[:, None]
    kj = jnp.arange(2 * BLK)[None, :]
    dist = BLK + qi - kj
    band = (dist >= 0) & (dist <= win // dil)
    has_prev = (jnp.arange(nb)[:, None, None] > 0) | (kj[None] >= BLK)
    valid = band[None] & has_prev
    sc = jnp.where(valid[None, None, :, None], sc, -jnp.inf)
    m = sc.max(-1)
    p = jnp.exp(sc - m[..., None])
    den = p.sum(-1)
    o = jnp.einsum('bgnhqk,bgnkhc->bgnqhc', p, vv.astype(jnp.float32))
    m = jnp.moveaxis(m, 3, 4)
    den = jnp.moveaxis(den, 3, 4)
    return _unfold(o, s), _unfold(m, s), _unfold(den, s)


def branch_sample(q, kcat, vcat, win, dil):
    t = q.shape[1]
    past = kcat.shape[1] - t
    idx = past + jnp.arange(t)[:, None] - dil * jnp.arange(win // dil + 1)[None, :]
    valid = idx >= 0
    idx = jnp.maximum(idx, 0)
    kg = kcat[:, idx]
    vg = vcat[:, idx]
    sc = jnp.einsum('bthc,btjhc->bthj', q, kg, preferred_element_type=jnp.float32)
    sc = jnp.where(valid[None, :, None, :], sc, -jnp.inf)
    m = sc.max(-1)
    p = jnp.exp(sc - m[..., None])
    den = p.sum(-1)
    o = jnp.einsum('bthj,btjhc->bthc', p, vg.astype(jnp.float32))
    return o, m, den


def merge_branches(parts):
    o = jnp.stack([pt[0] for pt in parts])
    m = jnp.stack([pt[1] for pt in parts])
    d = jnp.stack([pt[2] for pt in parts])
    w = jnp.exp(m - m.max(0, keepdims=True))
    return (w[..., None] * o).sum(0) / (w * d).sum(0)[..., None]


def conv_rglru(u, conv_buf, h0, conv_w, conv_b, w_a, b_a, w_x, b_x, lam):
    b, t, r = u.shape
    full = jnp.concatenate([conv_buf.astype(u.dtype), u], axis=1)
    xc = conv_b + conv_w[0] * full[:, 0:t]
    for j in range(1, CONV_WIDTH):
        xc = xc + conv_w[j] * full[:, j:j + t]
    new_buf = full[:, t:]
    xf = xc.astype(jnp.float32)
    xb = xf.reshape(b, t, N_RNN_BLOCKS, RNN_BLOCK)
    rg = jax.nn.sigmoid(jnp.einsum('btnc,ncd->btnd', xb, w_a.astype(jnp.float32)) + b_a.astype(jnp.float32)).reshape(b, t, r)
    ig = jax.nn.sigmoid(jnp.einsum('btnc,ncd->btnd', xb, w_x.astype(jnp.float32)) + b_x.astype(jnp.float32)).reshape(b, t, r)
    log_a = -LRU_C * rg * jax.nn.softplus(-lam.astype(jnp.float32))
    a = jnp.exp(log_a)
    bt = jnp.sqrt(-jnp.expm1(2.0 * log_a)) * ig * xf
    bt = bt.at[:, 0].add(a[:, 0] * h0.astype(jnp.float32))

    def comb(lhs, rhs):
        a1, b1 = lhs
        a2, b2 = rhs
        return a1 * a2, a2 * b1 + b2

    _, hs = lax.associative_scan(comb, (a, bt), axis=1)
    return hs.astype(u.dtype), hs[:, -1].astype(u.dtype), new_buf


def decoder_layer(x, conv_buf, h0, k_past, v_past, lw):
    (ln1, w1g, w1u, w1d, ln_m, w_in, conv_w, conv_b, w_a, b_a, w_x, b_x, lam,
     w_out, ln2, w2g, w2u, w2d) = lw
    b, t, _ = x.shape
    x = x + 0.5 * swiglu(rmsnorm(x, ln1), w1g, w1u, w1d)
    z = rmsnorm(x, ln_m) @ w_in
    q, k, v, u, g = jnp.split(z, [D_ATTN, 2 * D_ATTN, 3 * D_ATTN, 3 * D_ATTN + D_RNN], axis=-1)
    q = q.reshape(b, t, N_HEADS, HEAD_DIM) * (HEAD_DIM ** -0.5)
    k = k.reshape(b, t, N_HEADS, HEAD_DIM)
    v = v.reshape(b, t, N_HEADS, HEAD_DIM)
    if k_past is None:
        parts = [branch_prompt(q, k, v, win, dil) for win, dil in DILATED]
        keep = min(MAX_WINDOW, t)
        k_state, v_state = k[:, t - keep:], v[:, t - keep:]
    else:
        kcat = jnp.concatenate([k_past.astype(k.dtype), k], axis=1)
        vcat = jnp.concatenate([v_past.astype(v.dtype), v], axis=1)
        parts = [branch_sample(q, kcat, vcat, win, dil) for win, dil in DILATED]
        k_state, v_state = k, v
    attn = merge_branches(parts).astype(x.dtype).reshape(b, t, D_ATTN)
    rnn, h_last, new_buf = conv_rglru(u, conv_buf, h0, conv_w, conv_b, w_a, b_a, w_x, b_x, lam)
    x = x + jnp.concatenate([attn, rnn * jax.nn.gelu(g)], axis=-1) @ w_out
    x = x + 0.5 * swiglu(rmsnorm(x, ln2), w2g, w2u, w2d)
    return x, k_state, v_state, h_last, new_buf


def setup_inputs(seed: int = 0) -> dict:
    key = jax.random.key(seed)
    ks = jax.random.split(key, 32)
    w_buf = min(MAX_WINDOW, PAST_LEN)

    def nrm(k, shape, scale):
        return jax.random.normal(k, shape, jnp.float32) * scale

    a0 = jax.random.uniform(ks[18], (DEPTH, D_RNN), jnp.float32, 0.9, 0.999)
    sig = a0 ** (1.0 / LRU_C)
    lru_lambda = jnp.log(sig) - jnp.log1p(-sig)
    return {
        'x_prompt': nrm(ks[0], (BATCH, SEQ, D_MODEL), 1.0),
        'x_sample': nrm(ks[1], (DEC_BATCH, DEC_SEQ, D_MODEL), 1.0),
        'cache_k_win': nrm(ks[2], (DEPTH, DEC_BATCH, w_buf, N_HEADS, HEAD_DIM), 1.0),
        'cache_v_win': nrm(ks[3], (DEPTH, DEC_BATCH, w_buf, N_HEADS, HEAD_DIM), 1.0),
        'state_lru_h': nrm(ks[4], (DEPTH, DEC_BATCH, D_RNN), 0.5),
        'state_lru_conv': nrm(ks[5], (DEPTH, DEC_BATCH, CONV_WIDTH - 1, D_RNN), 1.0),
        'ln_ffn1': 1.0 + nrm(ks[6], (DEPTH, D_MODEL), 0.02),
        'w_ffn1_gate': nrm(ks[7], (DEPTH, D_MODEL, D_FF), D_MODEL ** -0.5),
        'w_ffn1_up': nrm(ks[8], (DEPTH, D_MODEL, D_FF), D_MODEL ** -0.5),
        'w_ffn1_down': nrm(ks[9], (DEPTH, D_FF, D_MODEL), D_FF ** -0.5),
        'ln_mix': 1.0 + nrm(ks[10], (DEPTH, D_MODEL), 0.02),
        'w_in': nrm(ks[11], (DEPTH, D_MODEL, IN_COLS), D_MODEL ** -0.5),
        'conv_w': nrm(ks[12], (DEPTH, CONV_WIDTH, D_RNN), CONV_WIDTH ** -0.5),
        'conv_b': nrm(ks[13], (DEPTH, D_RNN), 0.01),
        'w_gate_a': nrm(ks[14], (DEPTH, N_RNN_BLOCKS, RNN_BLOCK, RNN_BLOCK), RNN_BLOCK ** -0.5),
        'b_gate_a': nrm(ks[15], (DEPTH, N_RNN_BLOCKS, RNN_BLOCK), 0.01),
        'w_gate_x': nrm(ks[16], (DEPTH, N_RNN_BLOCKS, RNN_BLOCK, RNN_BLOCK), RNN_BLOCK ** -0.5),
        'b_gate_x': nrm(ks[17], (DEPTH, N_RNN_BLOCKS, RNN_BLOCK), 0.01),
        'lru_lambda': lru_lambda,
        'w_out': nrm(ks[19], (DEPTH, D_MIX, D_MODEL), D_MIX ** -0.5),
        'ln_ffn2': 1.0 + nrm(ks[20], (DEPTH, D_MODEL), 0.02),
        'w_ffn2_gate': nrm(ks[21], (DEPTH, D_MODEL, D_FF), D_MODEL ** -0.5),
        'w_ffn2_up': nrm(ks[22], (DEPTH, D_MODEL, D_FF), D_MODEL ** -0.5),
        'w_ffn2_down': nrm(ks[23], (DEPTH, D_FF, D_MODEL), D_FF ** -0.5),
        'ln_final': 1.0 + nrm(ks[24], (D_MODEL,), 0.02),
    }


def reference(x_prompt, x_sample, cache_k_win, cache_v_win, state_lru_h, state_lru_conv,
              ln_ffn1, w_ffn1_gate, w_ffn1_up, w_ffn1_down, ln_mix, w_in, conv_w, conv_b,
              w_gate_a, b_gate_a, w_gate_x, b_gate_x, lru_lambda, w_out,
              ln_ffn2, w_ffn2_gate, w_ffn2_up, w_ffn2_down, ln_final):
    xp, xs = x_prompt, x_sample
    bp = xp.shape[0]
    kp_l, vp_l, hp_l, cp_l = [], [], [], []
    ks_l, vs_l, hs_l, cs_l = [], [], [], []
    for l in range(DEPTH):
        lw = (ln_ffn1[l], w_ffn1_gate[l], w_ffn1_up[l], w_ffn1_down[l], ln_mix[l], w_in[l],
              conv_w[l], conv_b[l], w_gate_a[l], b_gate_a[l], w_gate_x[l], b_gate_x[l],
              lru_lambda[l], w_out[l], ln_ffn2[l], w_ffn2_gate[l], w_ffn2_up[l], w_ffn2_down[l])
        zero_buf = jnp.zeros((bp, CONV_WIDTH - 1, D_RNN), xp.dtype)
        zero_h = jnp.zeros((bp, D_RNN), xp.dtype)
        xp, kp, vp, hp, cp = decoder_layer(xp, zero_buf, zero_h, None, None, lw)
        xs, kn, vn, hn, cn = decoder_layer(xs, state_lru_conv[l], state_lru_h[l],
                                           cache_k_win[l], cache_v_win[l], lw)
        kp_l.append(kp); vp_l.append(vp); hp_l.append(hp); cp_l.append(cp)
        ks_l.append(kn); vs_l.append(vn); hs_l.append(hn); cs_l.append(cn)
    y_prompt = rmsnorm(xp, ln_final)
    y_sample = rmsnorm(xs, ln_final)
    return (y_prompt, y_sample,
            jnp.stack(kp_l), jnp.stack(vp_l), jnp.stack(hp_l), jnp.stack(cp_l),
            jnp.stack(ks_l), jnp.stack(vs_l), jnp.stack(hs_l), jnp.stack(cs_l))
```

```cpp
#define MK_N_LAUNCHES 10
#include <hip/hip_runtime.h>
#include <cstdio>
#include <cstdint>
namespace pg8 {
#define PG8_LAS __attribute__((address_space(3)))
typedef unsigned short bf16_t;
typedef short bf16x8 __attribute__((ext_vector_type(8)));
typedef float f32x4 __attribute__((ext_vector_type(4)));
typedef unsigned u32x4 __attribute__((ext_vector_type(4)));
constexpr int BM = 256, BK = 64, HALF = 128, HTB = HALF * BK * 2  , STAGE_BYTES = 8 * HTB, NXCD = 8, WGM = 8;

__host__ __device__ __forceinline__ int lds_byte(int r, int c) { const int st = (r >> 4) * 2 + (c >> 5), rr = r & 15, cc = c & 31, ob = rr * 64 + cc * 2; return st * 1024 + (ob ^ (((ob >> 9) & 1) << 5)); }
__host__ __device__ __forceinline__ void stage_rc(int b, int& R, int& C) { const int st = b / 1024, sb = b % 1024, swz = sb ^ (((sb >> 9) & 1) << 5); R = (st >> 1) * 16 + swz / 64; C = (st & 1) * 32 + (swz % 64) / 2; }
__host__ __device__ __forceinline__ int perm32(int rho) { const int n = rho >> 4, i = rho & 15; return 8 * (i >> 2) + 4 * n + (i & 3); }

struct Unit { int pm, pn; };
struct Gemm { const bf16_t* A; const bf16_t* Bt; int M, N, K; };

struct StaticOrder {
    int nM, nN, nwg, G, c;
    __host__ __device__ void init(int M, int N, int G_, int c_) { nM = M / BM; nN = N / BM; nwg = nM * nN; G = G_; c = c_; }
    __host__ __device__ bool next(int i, Unit& u) const {
        const long L = (long)i * G + c; if (L >= nwg) return false;
        int wgid = (int)L; { const int q = nwg / NXCD, r = nwg % NXCD, xcd = wgid % NXCD, off = wgid / NXCD; wgid = (xcd < r ? xcd * (q + 1) : r * (q + 1) + (xcd - r) * q) + off; }
        const int nig = WGM * nN, gid = wgid / nig, fm = gid * WGM, gsz = (nM - fm) < WGM ? (nM - fm) : WGM;
        u.pm = fm + ((wgid % nig) % gsz); u.pn = (wgid % nig) / gsz; return true;
    }
    __device__ __forceinline__ void a_ready(const Unit&) const {}
    __device__ __forceinline__ void done(const Unit&) const {}
};
__device__ __forceinline__ unsigned cvt_pk_bf16(float lo, float hi) { unsigned r; asm volatile("v_cvt_pk_bf16_f32 %0, %1, %2" : "=v"(r) : "v"(lo), "v"(hi)); return r; }
typedef float f32x2 __attribute__((ext_vector_type(2)));
constexpr int E_DM = 1024, E_MP = 65536, E_MROWS = 66560;
constexpr size_t E_O_KWP = 68157440, E_O_VWP = 76546048, E_O_KNS = 84951040, E_O_VNS = 85475328;
constexpr float E_QSCALE = 0.125f * 1.4426950408889634f;
typedef unsigned u32x2 __attribute__((ext_vector_type(2)));
__device__ __forceinline__ float row_rs16(const float* ss, int row) {
    const f32x4* p = (const f32x4*)(ss + (size_t)row * 16);
    const f32x4 a = p[0], b = p[1], c = p[2], d = p[3];
    const float s = (((a[0] + a[1]) + (a[2] + a[3])) + ((b[0] + b[1]) + (b[2] + b[3]))) + (((c[0] + c[1]) + (c[2] + c[3])) + ((d[0] + d[1]) + (d[2] + d[3])));
    return __builtin_amdgcn_rsqf(s * (1.0f / 1024.0f) + 1e-6f);
}
struct EpiSwiGLU {
    static constexpr bool PERM = true, AFTER_DRAIN = false;
    bf16_t* H; const float* ss; int ldh;
    __device__ __forceinline__ void operator()(const f32x4 (&acc)[2][2][4][2], const Unit& u, int wr, int wc, int fr, int fq) const {
        const int row0 = u.pm * BM + wr * 64 + fr, col0 = u.pn * HALF + wc * 32 + 8 * fq;
#pragma unroll
        for (int ai = 0; ai < 2; ++ai) {
            float rs[4];
#pragma unroll
            for (int m = 0; m < 4; ++m) rs[m] = row_rs16(ss, row0 + ai * HALF + m * 16);
#pragma unroll
            for (int m = 0; m < 4; ++m) {
                const int row = row0 + ai * HALF + m * 16;
                float hv[8];
#pragma unroll
                for (int n = 0; n < 2; ++n)
#pragma unroll
                    for (int e = 0; e < 4; ++e) {
                        const float g = acc[ai][0][m][n][e] * rs[m], up = acc[ai][1][m][n][e] * rs[m];
                        const float sg = g * __builtin_amdgcn_rcpf(1.0f + __builtin_amdgcn_exp2f(-1.4426950408889634f * g));
                        hv[n * 4 + e] = sg * up;
                    }
                u32x4 w; w.x = cvt_pk_bf16(hv[0], hv[1]); w.y = cvt_pk_bf16(hv[2], hv[3]); w.z = cvt_pk_bf16(hv[4], hv[5]); w.w = cvt_pk_bf16(hv[6], hv[7]);
                *(u32x4*)(H + (size_t)row * ldh + col0) = w;
            }
        }
    }
};
template <bool WB> struct EpiResid {
    static constexpr bool PERM = false, AFTER_DRAIN = false;
    const float* __restrict__ base; const float* __restrict__ base2; float* __restrict__ out; bf16_t* __restrict__ xb; float* __restrict__ ss; float alpha;
    __device__ __forceinline__ void operator()(const f32x4 (&acc)[2][2][4][2], const Unit& u, int wr, int wc, int fr, int fq) const {
        const int row0 = u.pm * BM + wr * 64 + fr, col0 = u.pn * BM + wc * 32 + 4 * fq;
        const float* bsel = (u.pm >= E_MP / BM) ? base2 - (size_t)E_MP * E_DM : base;
#pragma unroll
        for (int ai = 0; ai < 2; ++ai) {
            f32x4 pre[4][2][2];
#pragma unroll
            for (int m = 0; m < 4; ++m)
#pragma unroll
                for (int bj = 0; bj < 2; ++bj)
#pragma unroll
                    for (int n = 0; n < 2; ++n) pre[m][bj][n] = *(const f32x4*)(bsel + (size_t)(row0 + ai * HALF + m * 16) * E_DM + col0 + bj * HALF + n * 16);
#pragma unroll
            for (int m = 0; m < 4; ++m) {
                const int row = row0 + ai * HALF + m * 16; float q = 0.f;
#pragma unroll
                for (int bj = 0; bj < 2; ++bj)
#pragma unroll
                    for (int n = 0; n < 2; ++n) {
                        const size_t off = (size_t)row * E_DM + col0 + bj * HALF + n * 16;
                        const f32x4 o = pre[m][bj][n] + acc[ai][bj][m][n] * alpha;
                        *(f32x4*)(out + off) = o;
                        q += (o[0] * o[0] + o[1] * o[1]) + (o[2] * o[2] + o[3] * o[3]);
                        if (WB) { u32x2 w; w.x = cvt_pk_bf16(o[0], o[1]); w.y = cvt_pk_bf16(o[2], o[3]); *(u32x2*)(xb + off) = w; }
                    }
                q += __shfl_xor(q, 16); q += __shfl_xor(q, 32);
                if (fq == 0) ss[(size_t)row * 16 + u.pn * 4 + wc] = q;
            }
        }
    }
};
struct EpiZ {
    static constexpr bool PERM = true, AFTER_DRAIN = false;
    bf16_t* Z; const float* ss; float* outp;
    __device__ __forceinline__ void operator()(const f32x4 (&acc)[2][2][4][2], const Unit& u, int wr, int wc, int fr, int fq) const {
        const int t = u.pn >> 1, colt = (u.pn & 1) * BM;
        bf16_t* zb = Z + (size_t)t * ((size_t)E_MROWS * 512);
        const float sc = (t == 0) ? E_QSCALE : 1.0f;
        const int row0 = u.pm * BM + wr * 64 + fr, col0 = colt + wc * 32 + 8 * fq;
        const bool wout = (t == 1 || t == 2) && (u.pm >= 256 || (u.pm & 31) >= 24);
#pragma unroll
        for (int ai = 0; ai < 2; ++ai) {
            float rs[4];
#pragma unroll
            for (int m = 0; m < 4; ++m) rs[m] = row_rs16(ss, row0 + ai * HALF + m * 16) * sc;
#pragma unroll
            for (int m = 0; m < 4; ++m) {
                const int row = row0 + ai * HALF + m * 16;
                size_t oo = 0;
                if (wout) { if (row < E_MP) oo = (t == 1 ? E_O_KWP : E_O_VWP) + ((size_t)((row >> 13) * 2048 + (row & 8191) - 6144)) * 512; else oo = (t == 1 ? E_O_KNS : E_O_VNS) + (size_t)(row - E_MP) * 512; }
#pragma unroll
                for (int bj = 0; bj < 2; ++bj) {
                    const f32x4 v0 = acc[ai][bj][m][0] * rs[m], v1 = acc[ai][bj][m][1] * rs[m];
                    u32x4 w; w.x = cvt_pk_bf16(v0[0], v0[1]); w.y = cvt_pk_bf16(v0[2], v0[3]); w.z = cvt_pk_bf16(v1[0], v1[1]); w.w = cvt_pk_bf16(v1[2], v1[3]);
                    *(u32x4*)(zb + (size_t)row * 512 + col0 + bj * HALF) = w;
                    if (wout) { float* op = outp + oo + col0 + bj * HALF; *(f32x4*)op = v0; *(f32x4*)(op + 4) = v1; }
                }
            }
        }
    }
};

template <class Epi, class Sched, bool ALIGN_EPI = false, bool SP2 = false>
__device__ __forceinline__ void gemm_phase(PG8_LAS unsigned char* lds, const Gemm g, const Sched& S, const Epi& E) {
    const int tid = threadIdx.x, wid = __builtin_amdgcn_readfirstlane(tid >> 6), lane = tid & 63, wr = wid >> 2, wc = wid & 3, fr = lane & 15, fq = lane >> 4;
    const int K = g.K, nt = K / BK;
    unsigned voffA[2], voffB[2];
#pragma unroll
    for (int i = 0; i < 2; ++i) { int R, C; stage_rc(tid * 16 + i * 8192, R, C); const int Rb = Epi::PERM ? ((R & ~31) + perm32(R & 31)) : R;
        voffA[i] = (unsigned)(R * K + C) * 2u; voffB[i] = (unsigned)(Rb * K + C) * 2u; }
    const size_t kstep = (size_t)(BK * 2);
    const size_t hstep = (size_t)HALF * K * 2;
    const size_t tstep = 2 * hstep;
    const unsigned ldsw = (unsigned)wid * 1024u;
    const int aoff = lds_byte(wr * 64 + fr, fq * 8), boff = lds_byte(wc * 32 + fr, fq * 8);
#define PG8_SA(b, h) (((b) * 2 + (h)) * HTB)
#define PG8_SB(b, h) ((4 + (b) * 2 + (h)) * HTB)
#define PG8_STAGE(bufoff, gbase, voff) do { _Pragma("unroll") for (int _i = 0; _i < 2; ++_i) \
        __builtin_amdgcn_global_load_lds((const unsigned*)((const char*)(gbase) + (voff)[_i]), (PG8_LAS unsigned*)(lds + (bufoff) + ldsw + _i * 8192), 16, 0, 0); } while (0)
#define PG8_LDA(dst, b, h) do { _Pragma("unroll") for (int m = 0; m < 4; ++m) _Pragma("unroll") for (int k = 0; k < 2; ++k) dst[m][k] = *(const PG8_LAS bf16x8*)(lds + PG8_SA(b, h) + aoff + m * 2048 + k * 1024); } while (0)
#define PG8_LDB(dst, b, h) do { _Pragma("unroll") for (int n = 0; n < 2; ++n) _Pragma("unroll") for (int k = 0; k < 2; ++k) dst[n][k] = *(const PG8_LAS bf16x8*)(lds + PG8_SB(b, h) + boff + n * 2048 + k * 1024); } while (0)
#define PG8_MMA(ai, bj, At, Bt) do { __builtin_amdgcn_s_setprio(1); _Pragma("unroll") for (int m = 0; m < 4; ++m) _Pragma("unroll") for (int n = 0; n < 2; ++n) _Pragma("unroll") for (int k = 0; k < 2; ++k) \
        acc[ai][bj][m][n] = __builtin_amdgcn_mfma_f32_16x16x32_bf16(Bt[n][k], At[m][k], acc[ai][bj][m][n], 0, 0, 0); __builtin_amdgcn_s_setprio(0); } while (0)
#define PG8_WAIT_V(n) asm volatile("s_waitcnt vmcnt(" #n ")" ::: "memory")
#define PG8_WAIT_L(n) asm volatile("s_waitcnt lgkmcnt(" #n ")" ::: "memory")
#define PG8_BAR __builtin_amdgcn_s_barrier()
#define PG8_SCHED __builtin_amdgcn_sched_barrier(0)
    Unit cur, nxt; int ui = 0;
    if (!S.next(0, cur)) return;
    f32x4 acc[2][2][4][2];
#pragma unroll
    for (int a = 0; a < 2; ++a)
#pragma unroll
        for (int b = 0; b < 2; ++b)
#pragma unroll
            for (int m = 0; m < 4; ++m)
#pragma unroll
                for (int n = 0; n < 2; ++n) acc[a][b][m][n] = (f32x4){0.f, 0.f, 0.f, 0.f};
    bf16x8 At[4][2], B0[2][2], B1[2][2];
    const char* cA = (const char*)g.A + (size_t)cur.pm * tstep; const char* cB = (const char*)g.Bt + (size_t)cur.pn * tstep;
    S.a_ready(cur);
    if constexpr (SP2) {
        PG8_STAGE(PG8_SB(0, 0), cB, voffB); PG8_STAGE(PG8_SB(0, 1), cB + hstep, voffB); PG8_STAGE(PG8_SA(0, 0), cA, voffA); PG8_STAGE(PG8_SA(0, 1), cA + hstep, voffA);
        if (wr == 1) PG8_BAR;
        PG8_WAIT_V(2); PG8_BAR;
        PG8_STAGE(PG8_SB(1, 0), cB + kstep, voffB); PG8_STAGE(PG8_SA(1, 0), cA + kstep, voffA); PG8_STAGE(PG8_SB(1, 1), cB + hstep + kstep, voffB);
        PG8_WAIT_V(6); PG8_BAR;
    } else {
        PG8_STAGE(PG8_SB(0, 0), cB, voffB); PG8_STAGE(PG8_SA(0, 0), cA, voffA); PG8_STAGE(PG8_SB(0, 1), cB + hstep, voffB); PG8_STAGE(PG8_SA(0, 1), cA + hstep, voffA);
        if (wr == 1) PG8_BAR;
        PG8_WAIT_V(4); PG8_BAR;
        PG8_STAGE(PG8_SB(1, 0), cB + kstep, voffB); PG8_STAGE(PG8_SA(1, 0), cA + kstep, voffA); PG8_STAGE(PG8_SB(1, 1), cB + hstep + kstep, voffB);
        PG8_WAIT_V(6); PG8_BAR;
    }
    for (;;) {
        const bool has_next = S.next(ui + 1, nxt);
        const char* nA = has_next ? (const char*)g.A + (size_t)nxt.pm * tstep : cA; const char* nB = has_next ? (const char*)g.Bt + (size_t)nxt.pn * tstep : cB;
        for (int t = 0; t < nt; t += 2) {
            const bool last = (t == nt - 2);
            const char* a1 = cA + (size_t)(t + 1) * kstep;
            const char* a2 = last ? nA : cA + (size_t)(t + 2) * kstep; const char* b2 = last ? nB : cB + (size_t)(t + 2) * kstep;
            const char* a3 = a2 + kstep; const char* b3 = b2 + kstep;
            if (last && has_next) S.a_ready(nxt);
            if constexpr (SP2) {
            PG8_LDB(B0, 0, 0); PG8_LDB(B1, 0, 1); PG8_SCHED; PG8_LDA(At, 0, 0); PG8_STAGE(PG8_SA(1, 1), a1 + hstep, voffA);
            PG8_WAIT_V(8); PG8_WAIT_L(0); PG8_BAR; PG8_MMA(0, 0, At, B0); PG8_MMA(0, 1, At, B1); PG8_BAR; PG8_SCHED;
            PG8_LDA(At, 0, 1); PG8_STAGE(PG8_SB(0, 0), b2, voffB); PG8_STAGE(PG8_SB(0, 1), b2 + hstep, voffB); PG8_STAGE(PG8_SA(0, 0), a2, voffA);
            PG8_WAIT_V(8); PG8_WAIT_L(0); PG8_BAR; PG8_MMA(1, 0, At, B0); PG8_MMA(1, 1, At, B1); PG8_BAR; PG8_SCHED;
            PG8_LDB(B0, 1, 0); PG8_LDB(B1, 1, 1); PG8_SCHED; PG8_LDA(At, 1, 0); PG8_STAGE(PG8_SA(0, 1), a2 + hstep, voffA);
            PG8_WAIT_V(8); PG8_WAIT_L(0); PG8_BAR; PG8_MMA(0, 0, At, B0); PG8_MMA(0, 1, At, B1); PG8_BAR; PG8_SCHED;
            PG8_LDA(At, 1, 1); PG8_STAGE(PG8_SB(1, 0), b3, voffB); PG8_STAGE(PG8_SB(1, 1), b3 + hstep, voffB); PG8_STAGE(PG8_SA(1, 0), a3, voffA);
            PG8_WAIT_V(8); PG8_WAIT_L(0); PG8_BAR; PG8_MMA(1, 0, At, B0); PG8_MMA(1, 1, At, B1); PG8_BAR; PG8_SCHED;
            } else {
            PG8_LDB(B0, 0, 0); PG8_SCHED; PG8_LDA(At, 0, 0); PG8_STAGE(PG8_SA(1, 1), a1 + hstep, voffA);
            PG8_WAIT_L(8); PG8_BAR; PG8_WAIT_L(0); PG8_MMA(0, 0, At, B0); PG8_BAR; PG8_SCHED;
            PG8_LDB(B1, 0, 1); PG8_STAGE(PG8_SB(0, 0), b2, voffB);
            PG8_BAR; PG8_WAIT_L(0); PG8_MMA(0, 1, At, B1); PG8_BAR;
            PG8_LDA(At, 0, 1); PG8_STAGE(PG8_SA(0, 0), a2, voffA);
            PG8_BAR; PG8_WAIT_L(0); PG8_MMA(1, 0, At, B0); PG8_BAR; PG8_SCHED;
            PG8_STAGE(PG8_SB(0, 1), b2 + hstep, voffB);
            PG8_WAIT_V(6); PG8_BAR; PG8_MMA(1, 1, At, B1); PG8_BAR;
            PG8_LDB(B0, 1, 0); PG8_SCHED; PG8_LDA(At, 1, 0); PG8_STAGE(PG8_SA(0, 1), a2 + hstep, voffA);
            PG8_WAIT_L(8); PG8_BAR; PG8_WAIT_L(0); PG8_MMA(0, 0, At, B0); PG8_BAR; PG8_SCHED;
            PG8_LDB(B1, 1, 1); PG8_STAGE(PG8_SB(1, 0), b3, voffB);
            PG8_BAR; PG8_WAIT_L(0); PG8_MMA(0, 1, At, B1); PG8_BAR;
            PG8_LDA(At, 1, 1); PG8_STAGE(PG8_SA(1, 0), a3, voffA);
            PG8_BAR; PG8_WAIT_L(0); PG8_MMA(1, 0, At, B0); PG8_BAR; PG8_SCHED;
            PG8_STAGE(PG8_SB(1, 1), b3 + hstep, voffB);
            PG8_WAIT_V(6); PG8_BAR; PG8_MMA(1, 1, At, B1); PG8_BAR;
            }
        }
        if constexpr (ALIGN_EPI) { if (wr == 0) PG8_BAR; }
        if constexpr (!Epi::AFTER_DRAIN) { E(acc, cur, wr, wc, fr, fq); S.done(cur); }
        if (!has_next) break;
#pragma unroll
        for (int a = 0; a < 2; ++a)
#pragma unroll
            for (int b = 0; b < 2; ++b)
#pragma unroll
                for (int m = 0; m < 4; ++m)
#pragma unroll
                    for (int n = 0; n < 2; ++n) acc[a][b][m][n] = (f32x4){0.f, 0.f, 0.f, 0.f};
        cur = nxt; cA = nA; cB = nB; ++ui;
        if constexpr (ALIGN_EPI) { if (wr == 1) PG8_BAR; }
    }
    PG8_WAIT_V(0);
    if constexpr (!ALIGN_EPI) { if (wr == 0) PG8_BAR; }
    PG8_BAR;
    if constexpr (Epi::AFTER_DRAIN) { E.fused(acc, cur, wr, wc, fr, fq, lds, wid, lane); S.done(cur); }
#undef PG8_SA
#undef PG8_SB
#undef PG8_STAGE
#undef PG8_LDA
#undef PG8_LDB
#undef PG8_MMA
#undef PG8_WAIT_V
#undef PG8_WAIT_L
#undef PG8_BAR
#undef PG8_SCHED
}
}
#define GAS __attribute__((address_space(1)))
#define LAS __attribute__((address_space(3)))
typedef unsigned short bf16;
typedef unsigned v4u __attribute__((ext_vector_type(4)));
typedef float f32x4 __attribute__((ext_vector_type(4)));
typedef short bf16x8 __attribute__((ext_vector_type(8)));
typedef GAS unsigned gu32;
typedef GAS unsigned long long gu64;
#define RLX_AGENT __ATOMIC_RELAXED, __HIP_MEMORY_SCOPE_AGENT
#define LDS_WAIT() asm volatile("s_waitcnt lgkmcnt(0)" ::: "memory")
#define VM_WAIT() asm volatile("s_waitcnt vmcnt(0)" ::: "memory")
__device__ __forceinline__ unsigned long long rt() { return __builtin_amdgcn_s_memrealtime(); }
__device__ __forceinline__ unsigned f2bf(float f) { unsigned u = __builtin_bit_cast(unsigned, f); return (u + 0x7fffu + ((u >> 16) & 1u)) >> 16; }
__device__ __forceinline__ unsigned pk2(float lo, float hi) { return f2bf(lo) | (f2bf(hi) << 16); }

#define XB_TMO      128
#define XB_XCNT(j)  (256  + 64 * (j))
#define XB_XSUB(j)  (1280 + 64 * (j))
#define XB_XGEN(j)  (2304 + 64 * (j))
#define XB_TOP      3328
#define XB_TOPGEN   3392
#define XCD_BAR_WORDS 3456
#define XB_SPIN_CAP (1u << 18)

__device__ __forceinline__ unsigned xb_ld(unsigned* p)              { return __hip_atomic_load(p, __ATOMIC_RELAXED, __HIP_MEMORY_SCOPE_AGENT); }
__device__ __forceinline__ unsigned xb_add(unsigned* p, unsigned v) { return __hip_atomic_fetch_add(p, v, __ATOMIC_RELAXED, __HIP_MEMORY_SCOPE_AGENT); }
__device__ __forceinline__ unsigned xb_xcc_id() { return (unsigned)__builtin_amdgcn_s_getreg((3 << 11) | 20) & 0xFu; }
#define XB_SPIN(cond, bar) do { unsigned _sp = 0; while (cond) { __builtin_amdgcn_s_sleep(1); \
    if ((++_sp & 255u) == 0u) { if (xb_ld(&(bar)[XB_TMO])) break; if (_sp > XB_SPIN_CAP) { atomicAdd(&(bar)[XB_TMO], 1u); break; } } } } while (0)

struct XcdBarrier {
    unsigned* bar; unsigned x;
    volatile LAS unsigned* st;
};

__device__ __forceinline__ XcdBarrier xcd_barrier_post(unsigned* bar, volatile LAS unsigned* st) {
    XcdBarrier b; b.bar = bar; b.x = xb_xcc_id(); b.st = st;
    if (threadIdx.x == 0) (void)xb_add(&bar[XB_XCNT(b.x)], 1u);
    return b;
}
__device__ __forceinline__ void xcd_barrier_complete(unsigned* bar, unsigned x, unsigned& nloc, unsigned& nx) {
    const unsigned G = gridDim.x * gridDim.y * gridDim.z;
    unsigned sum, cnt, mine, sp = 0u;
    for (;;) {
        sum = 0u; cnt = 0u; mine = 0u;
#pragma unroll
        for (unsigned j = 0; j < 16; ++j) { const unsigned c = xb_ld(&bar[XB_XCNT(j)]); sum += c; cnt += (c > 0u) ? 1u : 0u; mine = (j == x) ? c : mine; }
        if (sum == G) break;
        __builtin_amdgcn_s_sleep(1);
        if ((++sp & 255u) == 0u) { if (xb_ld(&bar[XB_TMO])) break; if (sp > XB_SPIN_CAP) { atomicAdd(&bar[XB_TMO], 1u); break; } }
    }
    nloc = mine > 0u ? mine : 1u; nx = cnt > 0u ? cnt : 1u;
}

__device__ __forceinline__ void xcd_barrier(const XcdBarrier& b) {
    asm volatile("s_waitcnt vmcnt(0)" ::: "memory");
    __syncthreads();
    if (threadIdx.x == 0) {
        unsigned* bar = b.bar;
        __builtin_amdgcn_s_waitcnt(0);
        unsigned nloc = b.st[0], nx = b.st[1];
        if (nloc == 0u) { xcd_barrier_complete(bar, b.x, nloc, nx); b.st[0] = nloc; b.st[1] = nx; }
        const unsigned old = xb_add(&bar[XB_XSUB(b.x)], 1u);
        const unsigned gen = old / nloc;
        if (old + 1u == (gen + 1u) * nloc) {
            __builtin_amdgcn_fence(__ATOMIC_RELEASE, "agent");
            asm volatile("s_waitcnt vmcnt(0)" ::: "memory");
            const unsigned og = xb_add(&bar[XB_TOP], 1u);
            const unsigned tg = og / nx;
            if (og + 1u == (tg + 1u) * nx) xb_add(&bar[XB_TOPGEN], 1u);
            else XB_SPIN(xb_ld(&bar[XB_TOPGEN]) == tg, bar);
            __builtin_amdgcn_fence(__ATOMIC_ACQUIRE, "agent");
            xb_add(&bar[XB_XGEN(b.x)], 1u);
            asm volatile("s_waitcnt vmcnt(0)" ::: "memory");
        } else {
            XB_SPIN(xb_ld(&bar[XB_XGEN(b.x)]) == gen, bar);
            __builtin_amdgcn_fence(__ATOMIC_ACQUIRE, "agent");
            asm volatile("s_waitcnt vmcnt(0)" ::: "memory");
        }
    }
    __syncthreads();
}

constexpr int NWAVES = 8;
constexpr int DM = 1024, DFF = 2816, NHEAD = 8, HD = 64, DATT = 512, DRNN = 512;
constexpr int BATCH = 8, SEQ = 8192, DECB = 128, DECT = 8, WBUF = 2048;
constexpr int MP = BATCH * SEQ, MS = DECB * DECT, MROWS = MP + MS;
constexpr int NGU = 2 * DFF, NIN = 3 * DATT + 2 * DRNN;
constexpr int NCHUNK = SEQ / 256;
static_assert(MROWS % 256 == 0 && MROWS == pg8::E_MROWS && MP == pg8::E_MP && DM == pg8::E_DM, "shapes");
constexpr size_t O_Y = 0, O_KWP = 68157440, O_VWP = 76546048, O_LHP = 84934656, O_LCP = 84938752, O_KNS = 84951040, O_VNS = 85475328, O_LHS = 85999616, O_LCS = 86065152, O_END = 86261760;
static_assert(O_KWP == pg8::E_O_KWP && O_VWP == pg8::E_O_VWP && O_KNS == pg8::E_O_KNS && O_VNS == pg8::E_O_VNS, "offsets");
constexpr size_t MiB = 1u << 20;
constexpr size_t WS_CTL = 0, CTL_ZERO_BYTES = 1 * MiB;
constexpr size_t WS_W1GU = 2 * MiB, WS_W1D = 13 * MiB, WS_WIN = 19 * MiB, WS_WOUT = 24 * MiB, WS_W2GU = 26 * MiB, WS_W2D = 37 * MiB, WS_WGA = 43 * MiB, WS_WGX = 43 * MiB + 65536;
constexpr size_t WS_SS0 = 44 * MiB, WS_SS1 = 49 * MiB, WS_SS2 = 54 * MiB, WS_SS3 = 59 * MiB;
constexpr size_t WS_RSA = 64 * MiB, WS_RSB = 64 * MiB + 524288;
constexpr size_t WS_PL = 66 * MiB;
constexpr size_t WS_XB = 128 * MiB;
constexpr size_t WS_H = 258 * MiB;
constexpr size_t WS_PO = 258 * MiB;
constexpr size_t WS_Z = 616 * MiB;
constexpr size_t WS_MIX = 941 * MiB;
constexpr size_t WS_X1 = 1072 * MiB, WS_X2 = 1332 * MiB, WS_END = 1592 * MiB;
constexpr int CW_BAR = 4096;
constexpr int RING_OFF = 0, RING_BYTES = 131072;
constexpr int LDSCTL_OFF = RING_BYTES, MISC_OFF = LDSCTL_OFF + 320;
constexpr int LDS_BYTES = 147456;

struct Frame {
    LAS unsigned char* lds;
    volatile LAS unsigned* MISC;
    gu32* ctl;
    int tid, lane, wave;
    int vcu, G;
};

__device__ __forceinline__ float wave_sum(float v) {
#pragma unroll
    for (int o = 1; o < 64; o <<= 1) v += __shfl_xor(v, o);
    return v;
}
__device__ __forceinline__ float bf2f(unsigned short b) { return __builtin_bit_cast(float, (unsigned)b << 16); }
__device__ __forceinline__ float fsigmoid(float x) { return __builtin_amdgcn_rcpf(1.0f + __builtin_amdgcn_exp2f(-1.4426950408889634f * x)); }

__device__ __forceinline__ void p0_transpose_item(const float* W, int ldw, const float* ksc, int k0, int n0, bf16* WT, int K, int dst_row0, LAS float* scr, int lane) {
#pragma unroll 8
    for (int i = 0; i < 32; ++i) { const int kk = 2 * i + (lane >> 5); float v = W[(size_t)(k0 + kk) * ldw + n0 + (lane & 31)]; if (ksc) v *= ksc[k0 + kk]; scr[kk * 33 + (lane & 31)] = v; }
    LDS_WAIT(); asm volatile("" ::: "memory");
    const int c = lane & 7;
#pragma unroll
    for (int j = 0; j < 4; ++j) { const int n = (lane >> 3) + 8 * j; const LAS float* s = scr + (8 * c) * 33 + n;
        v4u o; o.x = pk2(s[0 * 33], s[1 * 33]); o.y = pk2(s[2 * 33], s[3 * 33]); o.z = pk2(s[4 * 33], s[5 * 33]); o.w = pk2(s[6 * 33], s[7 * 33]);
        *(GAS v4u*)(WT + (size_t)(dst_row0 + n) * K + k0 + 8 * c) = o; }
    LDS_WAIT(); asm volatile("" ::: "memory");
}
struct In { const float* p[25]; };
__device__ __forceinline__ void p0_prologue(Frame& F, const In& in, unsigned char* ws) {
    LAS float* scr = (LAS float*)(F.lds + RING_OFF + F.wave * 16384);
    const int gw = F.vcu * NWAVES + F.wave, NGW = F.G * NWAVES;
    constexpr int I_GU = (DM / 64) * (DFF / 32), I_D = (DFF / 64) * (DM / 32), I_IN = (DM / 64) * (NIN / 32), I_O = (DM / 64) * (DM / 32);
    constexpr int NITEMS = 4 * I_GU + 2 * I_D + I_IN + I_O;
    for (int it = gw; it < NITEMS; it += NGW) {
        int r = it;
        if (r < 4 * I_GU) {
            const int which = r / I_GU; r -= which * I_GU;
            const int nb = r % (DFF / 32), kb = r / (DFF / 32), n0 = 32 * nb;
            const float* W = in.p[which == 0 ? 7 : which == 1 ? 8 : which == 2 ? 21 : 22];
            const float* ln = in.p[which < 2 ? 6 : 20];
            bf16* WT = (bf16*)(ws + (which < 2 ? WS_W1GU : WS_W2GU));
            p0_transpose_item(W, DFF, ln, 64 * kb, n0, WT, DM, (n0 / 128) * 256 + (n0 % 128) + ((which & 1) ? 128 : 0), scr, F.lane);
            continue;
        }
        r -= 4 * I_GU;
        if (r < 2 * I_D) {
            const int which = r / I_D; r -= which * I_D;
            const int nb = r % (DM / 32), kb = r / (DM / 32);
            p0_transpose_item(in.p[which == 0 ? 9 : 23], DM, nullptr, 64 * kb, 32 * nb, (bf16*)(ws + (which == 0 ? WS_W1D : WS_W2D)), DFF, 32 * nb, scr, F.lane);
            continue;
        }
        r -= 2 * I_D;
        if (r < I_IN) { const int nb = r % (NIN / 32), kb = r / (NIN / 32); p0_transpose_item(in.p[11], NIN, in.p[10], 64 * kb, 32 * nb, (bf16*)(ws + WS_WIN), DM, 32 * nb, scr, F.lane); continue; }
        r -= I_IN;
        { const int nb = r % (DM / 32), kb = r / (DM / 32); p0_transpose_item(in.p[19], DM, nullptr, 64 * kb, 32 * nb, (bf16*)(ws + WS_WOUT), DM, 32 * nb, scr, F.lane); }
    }
    for (int e = (F.vcu * NWAVES + F.wave) * 64 + F.lane; e < 2 * 32768; e += NGW * 64) {
        const int which = e >> 15, r = e & 32767, n = r >> 12, d = (r >> 6) & 63, c = r & 63;
        const float v = in.p[which ? 16 : 14][(n * 64 + c) * 64 + d];
        ((bf16*)(ws + (which ? WS_WGX : WS_WGA)))[r] = (bf16)f2bf(v);
    }
    bf16* XB = (bf16*)(ws + WS_XB); float* SS0 = (float*)(ws + WS_SS0);
    for (int m = gw; m < MROWS; m += NGW) {
        const float* xrow = (m < MP) ? in.p[0] + (size_t)m * DM : in.p[1] + (size_t)(m - MP) * DM;
        const GAS f32x4* xr = (const GAS f32x4*)xrow + F.lane;
        f32x4 v[4]; float s = 0.f;
#pragma unroll
        for (int j = 0; j < 4; ++j) { v[j] = xr[64 * j]; s += (v[j].x * v[j].x + v[j].y * v[j].y) + (v[j].z * v[j].z + v[j].w * v[j].w); }
        s = wave_sum(s);
        GAS unsigned long long* o8 = (GAS unsigned long long*)(XB + (size_t)m * DM) + F.lane;
#pragma unroll
        for (int j = 0; j < 4; ++j) o8[64 * j] = (unsigned long long)pk2(v[j].x, v[j].y) | ((unsigned long long)pk2(v[j].z, v[j].w) << 32);
        if (F.lane < 16) SS0[(size_t)m * 16 + F.lane] = (F.lane == 0) ? s : 0.f;
    }
}

typedef short v4i16_t __attribute__((ext_vector_type(4)));
typedef unsigned u32x2_t __attribute__((ext_vector_type(2)));
__device__ __forceinline__ v4i16_t vtr(const LAS unsigned char* p) { return __builtin_amdgcn_ds_read_tr16_b64_v4i16((LAS v4i16_t*)p); }
constexpr int ATT_K = 0, ATT_V = 32768;

__device__ __forceinline__ void attn_stage(LAS unsigned char* lds, const bf16* Kg, const bf16* Vg, int rowbase, int h, int tok0, int dil, int tid) {
#pragma unroll
    for (int i = 0; i < 4; ++i) {
        const int c = tid + 512 * i, row = c >> 3, slot = c & 7;
        const int lc = (((slot >> 1) ^ ((row >> 1) & 3)) << 1) | (slot & 1);
        const int tok = tok0 + row * dil;
        v4u kv = (v4u){0u, 0u, 0u, 0u}, vv = (v4u){0u, 0u, 0u, 0u};
        if (tok >= 0) { const size_t off = (size_t)(rowbase + tok) * 512 + h * 64 + lc * 8; kv = *(const v4u*)(Kg + off); vv = *(const v4u*)(Vg + off); }
        *(LAS v4u*)(lds + ATT_K + c * 16) = kv; *(LAS v4u*)(lds + ATT_V + c * 16) = vv;
    }
}
template <int BR>
__device__ __forceinline__ void attn_compute(LAS unsigned char* lds, const bf16* Qg, bf16* PO, float* PL, bf16* MIX, int rowbase, int h, int s, int rho, int wave, int lane) {
    constexpr int dil = BR == 0 ? 1 : BR == 1 ? 4 : 16, span = 128 * dil;
    const int ii = lane & 15, g = lane >> 4, w = wave;
    const int tq = s * span + rho + (16 * w + ii) * dil;
    const size_t qrow = (size_t)(rowbase + tq);
    const bf16* qp = Qg + qrow * 512 + h * 64 + 8 * g;
    const bf16x8 q0 = *(const bf16x8*)qp, q1 = *(const bf16x8*)(qp + 32);
    const int xk = (ii >> 1) & 3;
    const LAS unsigned char* kbase = lds + ATT_K + ((16 * w + ii) * 128 + (g & 1) * 16);
    const LAS unsigned char* kb0 = kbase + ((((g >> 1)) ^ xk) << 5); const LAS unsigned char* kb1 = kbase + ((((g >> 1) + 2) ^ xk) << 5);
    f32x4 sc[9];
#pragma unroll
    for (int kt = 0; kt < 9; ++kt) {
        const bf16x8 a0 = *(const LAS bf16x8*)(kb0 + kt * 2048), a1 = *(const LAS bf16x8*)(kb1 + kt * 2048);
        f32x4 c = (f32x4){0.f, 0.f, 0.f, 0.f};
        c = __builtin_amdgcn_mfma_f32_16x16x32_bf16(a0, q0, c, 0, 0, 0);
        c = __builtin_amdgcn_mfma_f32_16x16x32_bf16(a1, q1, c, 0, 0, 0);
        sc[kt] = c;
    }
    const float NEG = -INFINITY;
#pragma unroll
    for (int r = 0; r < 4; ++r) { if (4 * g + r < ii) sc[0][r] = NEG; if (4 * g + r > ii) sc[8][r] = NEG; }
    if (s == 0) {
#pragma unroll
        for (int kt = 0; kt < 8; ++kt)
#pragma unroll
            for (int r = 0; r < 4; ++r) if (16 * w + 16 * kt + 4 * g + r < 128) sc[kt][r] = NEG;
    }
    float mx = NEG;
#pragma unroll
    for (int kt = 0; kt < 9; ++kt) mx = fmaxf(mx, fmaxf(fmaxf(sc[kt][0], sc[kt][1]), fmaxf(sc[kt][2], sc[kt][3])));
    mx = fmaxf(mx, __shfl_xor(mx, 16)); mx = fmaxf(mx, __shfl_xor(mx, 32));
    float ls = 0.f;
#pragma unroll
    for (int kt = 0; kt < 9; ++kt)
#pragma unroll
        for (int r = 0; r < 4; ++r) { const float p = __builtin_amdgcn_exp2f(sc[kt][r] - mx); sc[kt][r] = p; ls += p; }
    ls += __shfl_xor(ls, 16); ls += __shfl_xor(ls, 32);
    const int qv = ii >> 2, pp = ii & 3, xv = (2 * g + (qv >> 1)) & 3;
    const LAS unsigned char* vbase = lds + ATT_V + ((16 * w + 4 * g + qv) * 128 + 8 * pp);
    const LAS unsigned char* vb[4];
#pragma unroll
    for (int db = 0; db < 4; ++db) vb[db] = vbase + ((db ^ xv) << 5);
    f32x4 o[4];
#pragma unroll
    for (int db = 0; db < 4; ++db) o[db] = (f32x4){0.f, 0.f, 0.f, 0.f};
#pragma unroll
    for (int p = 0; p < 5; ++p) {
        pg8::u32x4 pw;
        pw.x = pg8::cvt_pk_bf16(sc[2 * p][0], sc[2 * p][1]); pw.y = pg8::cvt_pk_bf16(sc[2 * p][2], sc[2 * p][3]);
        if (p < 4) { pw.z = pg8::cvt_pk_bf16(sc[2 * p + 1][0], sc[2 * p + 1][1]); pw.w = pg8::cvt_pk_bf16(sc[2 * p + 1][2], sc[2 * p + 1][3]); } else { pw.z = 0u; pw.w = 0u; }
        const bf16x8 pb = __builtin_bit_cast(bf16x8, pw);
#pragma unroll
        for (int db = 0; db < 4; ++db) {
            const v4i16_t lo = vtr(vb[db] + p * 4096), hi = vtr(vb[db] + p * 4096 + (p < 4 ? 2048 : 0));
            const bf16x8 va = (bf16x8){lo[0], lo[1], lo[2], lo[3], hi[0], hi[1], hi[2], hi[3]};
            o[db] = __builtin_amdgcn_mfma_f32_16x16x32_bf16(va, pb, o[db], 0, 0, 0);
        }
    }
    const float linv = __builtin_amdgcn_rcpf(ls);
    const float lse = mx + __builtin_amdgcn_logf(ls);
    if (BR < 2) {
        bf16* po = PO + (size_t)BR * ((size_t)MP * 512) + qrow * 512 + h * 64 + 4 * g;
#pragma unroll
        for (int db = 0; db < 4; ++db) { u32x2_t wv; wv.x = pg8::cvt_pk_bf16(o[db][0] * linv, o[db][1] * linv); wv.y = pg8::cvt_pk_bf16(o[db][2] * linv, o[db][3] * linv); *(u32x2_t*)(po + 16 * db) = wv; }
        if (g == 0) PL[(size_t)BR * ((size_t)MP * 8) + qrow * 8 + h] = lse;
    } else {
        const float l0 = PL[qrow * 8 + h], l1 = PL[(size_t)MP * 8 + qrow * 8 + h];
        const float mm = fmaxf(fmaxf(l0, l1), lse);
        const float w0 = __builtin_amdgcn_exp2f(l0 - mm), w1 = __builtin_amdgcn_exp2f(l1 - mm), w2 = __builtin_amdgcn_exp2f(lse - mm);
        const float wi = __builtin_amdgcn_rcpf(w0 + w1 + w2);
        const float c0 = w0 * wi, c1 = w1 * wi, c2 = w2 * wi * linv;
        const bf16* p0 = PO + qrow * 512 + h * 64 + 4 * g; const bf16* p1 = p0 + (size_t)MP * 512;
        bf16* mo = MIX + qrow * 1024 + h * 64 + 4 * g;
#pragma unroll
        for (int db = 0; db < 4; ++db) {
            const u32x2_t a = *(const u32x2_t*)(p0 + 16 * db), b = *(const u32x2_t*)(p1 + 16 * db);
            const float r0 = c0 * __builtin_bit_cast(float, a.x << 16) + c1 * __builtin_bit_cast(float, b.x << 16) + c2 * o[db][0];
            const float r1 = c0 * __builtin_bit_cast(float, a.x & 0xffff0000u) + c1 * __builtin_bit_cast(float, b.x & 0xffff0000u) + c2 * o[db][1];
            const float r2 = c0 * __builtin_bit_cast(float, a.y << 16) + c1 * __builtin_bit_cast(float, b.y << 16) + c2 * o[db][2];
            const float r3 = c0 * __builtin_bit_cast(float, a.y & 0xffff0000u) + c1 * __builtin_bit_cast(float, b.y & 0xffff0000u) + c2 * o[db][3];
            u32x2_t wv; wv.x = pg8::cvt_pk_bf16(r0, r1); wv.y = pg8::cvt_pk_bf16(r2, r3); *(u32x2_t*)(mo + 16 * db) = wv;
        }
    }
}
__device__ __forceinline__ void attn_super(Frame& F, unsigned char* ws, int su) {
    const int S2 = su & 3, h = (su >> 2) & 7, b = su >> 5, rowbase = b * SEQ;
    const bf16* Qg = (const bf16*)(ws + WS_Z); const bf16* Kg = Qg + (size_t)MROWS * 512; const bf16* Vg = Kg + (size_t)MROWS * 512;
    bf16* PO = (bf16*)(ws + WS_PO); float* PL = (float*)(ws + WS_PL); bf16* MIX = (bf16*)(ws + WS_MIX);
    LAS unsigned char* lds = F.lds + RING_OFF;
    for (int lb = 0; lb < 16; ++lb) {
        const int s = S2 * 16 + lb;
        attn_stage(lds, Kg, Vg, rowbase, h, (s - 1) * 128, 1, F.tid);
        LDS_WAIT(); __builtin_amdgcn_s_barrier(); asm volatile("" ::: "memory");
        attn_compute<0>(lds, Qg, PO, PL, MIX, rowbase, h, s, 0, F.wave, F.lane);
        LDS_WAIT(); __builtin_amdgcn_s_barrier(); asm volatile("" ::: "memory");
    }
    for (int lb = 0; lb < 16; ++lb) {
        const int s = S2 * 4 + (lb >> 2), rho = lb & 3;
        attn_stage(lds, Kg, Vg, rowbase, h, (s - 1) * 512 + rho, 4, F.tid);
        LDS_WAIT(); __builtin_amdgcn_s_barrier(); asm volatile("" ::: "memory");
        attn_compute<1>(lds, Qg, PO, PL, MIX, rowbase, h, s, rho, F.wave, F.lane);
        LDS_WAIT(); __builtin_amdgcn_s_barrier(); asm volatile("" ::: "memory");
    }
    VM_WAIT(); __syncthreads(); __builtin_amdgcn_fence(__ATOMIC_ACQUIRE, "agent"); VM_WAIT();
    for (int lb = 0; lb < 16; ++lb) {
        attn_stage(lds, Kg, Vg, rowbase, h, (S2 - 1) * 2048 + lb, 16, F.tid);
        LDS_WAIT(); __builtin_amdgcn_s_barrier(); asm volatile("" ::: "memory");
        attn_compute<2>(lds, Qg, PO, PL, MIX, rowbase, h, S2, lb, F.wave, F.lane);
        LDS_WAIT(); __builtin_amdgcn_s_barrier(); asm volatile("" ::: "memory");
    }
}
__device__ __forceinline__ void attn_sample_item(const In& in, unsigned char* ws, float* outp, int b, int h, int t, int lane) {
    const int i = lane & 15, g = lane >> 4;
    const bf16* Qg = (const bf16*)(ws + WS_Z);
    const size_t srow = (size_t)MP + b * DECT + t;
    const u32x2_t qw = *(const u32x2_t*)(Qg + srow * 512 + h * 64 + 4 * i);
    const float q0 = __builtin_bit_cast(float, qw.x << 16), q1 = __builtin_bit_cast(float, qw.x & 0xffff0000u), q2 = __builtin_bit_cast(float, qw.y << 16), q3 = __builtin_bit_cast(float, qw.y & 0xffff0000u);
    const float* ck = in.p[2] + (size_t)b * WBUF * 512 + h * 64 + 4 * i; const float* cv = in.p[3] + (size_t)b * WBUF * 512 + h * 64 + 4 * i;
    const float* nk = outp + O_KNS + (size_t)b * DECT * 512 + h * 64 + 4 * i; const float* nv = outp + O_VNS + (size_t)b * DECT * 512 + h * 64 + 4 * i;
    float m = -INFINITY, l = 0.f; f32x4 o = (f32x4){0.f, 0.f, 0.f, 0.f};
#pragma unroll 1
    for (int br = 0; br < 3; ++br) {
        const int dil = br == 0 ? 1 : br == 1 ? 4 : 16;
        float sc[33];
#pragma unroll
        for (int it = 0; it < 33; ++it) {
            const int j = 4 * it + g; const int jj = j > 128 ? 128 : j; const int idx = WBUF + t - dil * jj;
            const float* kp = idx >= WBUF ? nk + (size_t)(idx - WBUF) * 512 : ck + (size_t)idx * 512;
            const f32x4 kv = *(const f32x4*)kp;
            float s = (q0 * kv[0] + q1 * kv[1]) + (q2 * kv[2] + q3 * kv[3]);
            s += __shfl_xor(s, 1); s += __shfl_xor(s, 2); s += __shfl_xor(s, 4); s += __shfl_xor(s, 8);
            sc[it] = j > 128 ? -INFINITY : s;
        }
        float mb = sc[0];
#pragma unroll
        for (int it = 1; it < 33; ++it) mb = fmaxf(mb, sc[it]);
        const float mn = fmaxf(m, mb), f = __builtin_amdgcn_exp2f(m - mn);
        l *= f; o = o * f; m = mn;
#pragma unroll
        for (int it = 0; it < 33; ++it) {
            const int j = 4 * it + g; const int jj = j > 128 ? 128 : j; const int idx = WBUF + t - dil * jj;
            const float* vp = idx >= WBUF ? nv + (size_t)(idx - WBUF) * 512 : cv + (size_t)idx * 512;
            const f32x4 vv = *(const f32x4*)vp;
            const float p = __builtin_amdgcn_exp2f(sc[it] - m);
            l += p; o = o + vv * p;
        }
    }
    float mm = fmaxf(m, __shfl_xor(m, 16)); mm = fmaxf(mm, __shfl_xor(mm, 32));
    const float f = __builtin_amdgcn_exp2f(m - mm);
    l *= f; o = o * f;
    l += __shfl_xor(l, 16); l += __shfl_xor(l, 32);
#pragma unroll
    for (int e = 0; e < 4; ++e) { float v = o[e]; v += __shfl_xor(v, 16); v += __shfl_xor(v, 32); o[e] = v; }
    if (g == 0) {
        const float li = __builtin_amdgcn_rcpf(l);
        u32x2_t wv; wv.x = pg8::cvt_pk_bf16(o[0] * li, o[1] * li); wv.y = pg8::cvt_pk_bf16(o[2] * li, o[3] * li);
        *(u32x2_t*)((bf16*)(ws + WS_MIX) + srow * 1024 + h * 64 + 4 * i) = wv;
    }
}

constexpr int RL_XCB = 0, RL_XCB_PITCH = 1040;
constexpr int RL_PITCH = 516;
constexpr int RL_XCF = 16640, RL_AL = RL_XCF + 16 * RL_PITCH * 4, RL_BL = RL_AL + 16 * RL_PITCH * 4, RL_END = RL_BL + 16 * RL_PITCH * 4;
static_assert(RL_END <= RING_BYTES, "rnn LDS");
template <bool PASS2>
__device__ __forceinline__ void rnn_segment(Frame& F, const In& in, unsigned char* ws, int row0, int ntok, float hu3, float hu2, float hu1, float h0, float& ra, float& rb, float (&hu)[3]) {
    LAS unsigned char* lds = F.lds + RING_OFF;
    const bf16* Ub = (const bf16*)(ws + WS_Z) + (size_t)3 * MROWS * 512; const bf16* Gb = Ub + (size_t)MROWS * 512;
    bf16* MIX = (bf16*)(ws + WS_MIX);
    const int ch = F.tid, n = F.wave, i = F.lane & 15, g = F.lane >> 4;
    const float cw0 = in.p[12][ch], cw1 = in.p[12][512 + ch], cw2 = in.p[12][1024 + ch], cw3 = in.p[12][1536 + ch], cb = in.p[13][ch];
    float ba[4], bx[4], sp8[4]; bf16x8 wa[4][2], wx[4][2];
    const bf16* WA = (const bf16*)(ws + WS_WGA) + n * 4096; const bf16* WX = (const bf16*)(ws + WS_WGX) + n * 4096;
#pragma unroll
    for (int db = 0; db < 4; ++db) {
        const int c = 64 * n + 16 * db + i;
        ba[db] = in.p[15][c]; bx[db] = in.p[17][c];
        sp8[db] = 8.0f * log1pf(expf(-in.p[18][c]));
#pragma unroll
        for (int ks = 0; ks < 2; ++ks) { wa[db][ks] = *(const bf16x8*)(WA + (16 * db + i) * 64 + 8 * g + 32 * ks); wx[db][ks] = *(const bf16x8*)(WX + (16 * db + i) * 64 + 8 * g + 32 * ks); }
    }
    float u3 = hu3, u2 = hu2, u1 = hu1, h = h0, P = 1.0f;
    LAS float* XCF = (LAS float*)(lds + RL_XCF); LAS float* AL = (LAS float*)(lds + RL_AL); LAS float* BL = (LAS float*)(lds + RL_BL);
    const int nsub = (ntok + 15) >> 4;
    for (int sb = 0; sb < nsub; ++sb) {
        const int nv = (ntok - 16 * sb) < 16 ? (ntok - 16 * sb) : 16;
        const size_t r0 = (size_t)row0 + 16 * sb;
        unsigned short uraw[16];
#pragma unroll
        for (int tt = 0; tt < 16; ++tt) uraw[tt] = (tt < nv) ? Ub[(r0 + tt) * 512 + ch] : (unsigned short)0;
#pragma unroll
        for (int tt = 0; tt < 16; ++tt) {
            float xc = 0.f;
            if (tt < nv) { const float u0 = bf2f(uraw[tt]); xc = cb + cw0 * u3 + cw1 * u2 + cw2 * u1 + cw3 * u0; u3 = u2; u2 = u1; u1 = u0; }
            XCF[tt * RL_PITCH + ch] = xc;
            *(LAS unsigned short*)(lds + RL_XCB + tt * RL_XCB_PITCH + ch * 2) = (unsigned short)f2bf(xc);
        }
        LDS_WAIT(); __builtin_amdgcn_s_barrier(); asm volatile("" ::: "memory");
        {
            const bf16x8 a0 = *(const LAS bf16x8*)(lds + RL_XCB + i * RL_XCB_PITCH + (64 * n + 8 * g) * 2), a1 = *(const LAS bf16x8*)(lds + RL_XCB + i * RL_XCB_PITCH + (64 * n + 8 * g + 32) * 2);
#pragma unroll
            for (int db = 0; db < 4; ++db) {
                f32x4 da = (f32x4){0.f, 0.f, 0.f, 0.f}, dx = (f32x4){0.f, 0.f, 0.f, 0.f};
                da = __builtin_amdgcn_mfma_f32_16x16x32_bf16(a0, wa[db][0], da, 0, 0, 0); da = __builtin_amdgcn_mfma_f32_16x16x32_bf16(a1, wa[db][1], da, 0, 0, 0);
                dx = __builtin_amdgcn_mfma_f32_16x16x32_bf16(a0, wx[db][0], dx, 0, 0, 0); dx = __builtin_amdgcn_mfma_f32_16x16x32_bf16(a1, wx[db][1], dx, 0, 0, 0);
                const int c = 64 * n + 16 * db + i;
#pragma unroll
                for (int r = 0; r < 4; ++r) {
                    const int tok = 4 * g + r;
                    const float xcv = XCF[tok * RL_PITCH + c];
                    const float rg = fsigmoid(da[r] + ba[db]), ig = fsigmoid(dx[r] + bx[db]);
                    const float log_a = -rg * sp8[db];
                    const float a = __builtin_amdgcn_exp2f(1.4426950408889634f * log_a);
                    const float bt = sqrtf(-expm1f(2.0f * log_a)) * ig * xcv;
                    AL[tok * RL_PITCH + c] = a; BL[tok * RL_PITCH + c] = bt;
                }
            }
        }
        LDS_WAIT(); __builtin_amdgcn_s_barrier(); asm volatile("" ::: "memory");
        if (PASS2) {
            unsigned short graw[16];
#pragma unroll
            for (int tt = 0; tt < 16; ++tt) graw[tt] = (tt < nv) ? Gb[(r0 + tt) * 512 + ch] : (unsigned short)0;
#pragma unroll
            for (int tt = 0; tt < 16; ++tt) if (tt < nv) {
                h = AL[tt * RL_PITCH + ch] * h + BL[tt * RL_PITCH + ch];
                const float gv = bf2f(graw[tt]);
                const float z2 = 1.5957691216057308f * (gv + 0.044715f * gv * gv * gv);
                MIX[(r0 + tt) * 1024 + 512 + ch] = (bf16)f2bf(h * gv * fsigmoid(z2));
            }
        } else {
#pragma unroll
            for (int tt = 0; tt < 16; ++tt) if (tt < nv) { const float a = AL[tt * RL_PITCH + ch]; h = a * h + BL[tt * RL_PITCH + ch]; P *= a; }
        }
    }
    LDS_WAIT(); __builtin_amdgcn_s_barrier(); asm volatile("" ::: "memory");
    ra = P; rb = h; hu[0] = u3; hu[1] = u2; hu[2] = u1;
}

struct Args { In in; float* out; unsigned char* ws; int ph_lo, ph_hi; };
constexpr int N_PHASES = 10;
__global__ void __launch_bounds__(NWAVES * 64, 2) mega_fwd(Args args) {
    extern __shared__ __attribute__((aligned(16))) unsigned char lds[];
    Frame F;
    F.lds = (LAS unsigned char*)lds;
    F.MISC = (volatile LAS unsigned*)(F.lds + MISC_OFF);
    F.tid = threadIdx.x; F.lane = F.tid & 63; F.wave = __builtin_amdgcn_readfirstlane(F.tid >> 6);
    F.G = gridDim.x; { const int bx = blockIdx.x; F.vcu = (F.G % 8 == 0) ? (bx % 8) * (F.G / 8) + bx / 8 : bx; }
    unsigned char* ws = args.ws; float* outp = args.out; const In& in = args.in;
    F.ctl = (gu32*)(ws + WS_CTL);
    for (int u = F.tid; u < (LDS_BYTES - LDSCTL_OFF) / 4; u += NWAVES * 64) ((LAS unsigned*)(F.lds + LDSCTL_OFF))[u] = 0u;
    __syncthreads();
    const int lo = args.ph_lo, hi = args.ph_hi;
    const bool use_bar = (hi - lo) > 1;
    XcdBarrier bar; bar.bar = (unsigned*)(F.ctl + CW_BAR); bar.x = 0; bar.st = nullptr;
    if (use_bar) bar = xcd_barrier_post((unsigned*)(F.ctl + CW_BAR), F.MISC + 8);
#define IN(k) (lo <= (k) && (k) < hi)
#define SEAM(k) do { if (IN(k) && IN((k) + 1)) xcd_barrier(bar); } while (0)
    bf16* XB = (bf16*)(ws + WS_XB); bf16* HB = (bf16*)(ws + WS_H); bf16* ZB = (bf16*)(ws + WS_Z); bf16* MIXB = (bf16*)(ws + WS_MIX);
    float* X1 = (float*)(ws + WS_X1); float* X2 = (float*)(ws + WS_X2);
    float* SS0 = (float*)(ws + WS_SS0); float* SS1 = (float*)(ws + WS_SS1); float* SS2 = (float*)(ws + WS_SS2); float* SS3 = (float*)(ws + WS_SS3);

    if (IN(0)) { p0_prologue(F, in, ws); }
    SEAM(0);
    if (IN(1)) {
        pg8::Gemm g{XB, (const bf16*)(ws + WS_W1GU), MROWS, NGU, DM}; pg8::StaticOrder S; S.init(MROWS, NGU, F.G, (int)blockIdx.x);
        pg8::EpiSwiGLU E{HB, SS0, DFF};
        pg8::gemm_phase<pg8::EpiSwiGLU, pg8::StaticOrder, true, true>(F.lds + RING_OFF, g, S, E);
    }
    SEAM(1);
    if (IN(2)) {
        pg8::Gemm g{HB, (const bf16*)(ws + WS_W1D), MROWS, DM, DFF}; pg8::StaticOrder S; S.init(MROWS, DM, F.G, (int)blockIdx.x);
        pg8::EpiResid<true> E{in.p[0], in.p[1], X1, XB, SS1, 0.5f};
        pg8::gemm_phase<pg8::EpiResid<true>, pg8::StaticOrder, true, true>(F.lds + RING_OFF, g, S, E);
    }
    SEAM(2);
    if (IN(3)) {
        pg8::Gemm g{XB, (const bf16*)(ws + WS_WIN), MROWS, NIN, DM}; pg8::StaticOrder S; S.init(MROWS, NIN, F.G, (int)blockIdx.x);
        pg8::EpiZ E{ZB, SS1, outp};
        pg8::gemm_phase<pg8::EpiZ, pg8::StaticOrder, true, true>(F.lds + RING_OFF, g, S, E);
    }
    SEAM(3);
    if (IN(4)) {
        for (int pr = F.vcu; pr < DECB * NHEAD; pr += F.G) attn_sample_item(in, ws, outp, pr >> 3, pr & 7, F.wave, F.lane);
        for (int su = F.vcu; su < 256; su += F.G) attn_super(F, ws, su);
        for (int ru = F.vcu; ru < BATCH * NCHUNK; ru += F.G) {
            const int b = ru / NCHUNK, c = ru % NCHUNK, row0 = b * SEQ + c * 256;
            const bf16* Ub = (const bf16*)(ws + WS_Z) + (size_t)3 * MROWS * 512;
            float h3 = 0.f, h2 = 0.f, h1 = 0.f;
            if (c > 0) { h3 = bf2f(Ub[(size_t)(row0 - 3) * 512 + F.tid]); h2 = bf2f(Ub[(size_t)(row0 - 2) * 512 + F.tid]); h1 = bf2f(Ub[(size_t)(row0 - 1) * 512 + F.tid]); }
            float ra, rb, hu[3];
            rnn_segment<false>(F, in, ws, row0, 256, h3, h2, h1, 0.f, ra, rb, hu);
            ((float*)(ws + WS_RSA))[(size_t)ru * 512 + F.tid] = ra; ((float*)(ws + WS_RSB))[(size_t)ru * 512 + F.tid] = rb;
        }
    }
    SEAM(4);
    if (IN(5)) {
        const bf16* Ub = (const bf16*)(ws + WS_Z) + (size_t)3 * MROWS * 512;
        for (int ru = F.vcu; ru < BATCH * NCHUNK + DECB; ru += F.G) {
            float ra, rb, hu[3];
            if (ru < BATCH * NCHUNK) {
                const int b = ru / NCHUNK, c = ru % NCHUNK, row0 = b * SEQ + c * 256;
                float h3 = 0.f, h2 = 0.f, h1 = 0.f, h0 = 0.f;
                if (c > 0) { h3 = bf2f(Ub[(size_t)(row0 - 3) * 512 + F.tid]); h2 = bf2f(Ub[(size_t)(row0 - 2) * 512 + F.tid]); h1 = bf2f(Ub[(size_t)(row0 - 1) * 512 + F.tid]); }
                const float* RA = (const float*)(ws + WS_RSA) + (size_t)b * NCHUNK * 512 + F.tid; const float* RB = (const float*)(ws + WS_RSB) + (size_t)b * NCHUNK * 512 + F.tid;
                for (int cc = 0; cc < c; ++cc) h0 = RA[cc * 512] * h0 + RB[cc * 512];
                rnn_segment<true>(F, in, ws, row0, 256, h3, h2, h1, h0, ra, rb, hu);
                if (c == NCHUNK - 1) {
                    outp[O_LHP + b * 512 + F.tid] = rb;
                    outp[O_LCP + (b * 3 + 0) * 512 + F.tid] = hu[0]; outp[O_LCP + (b * 3 + 1) * 512 + F.tid] = hu[1]; outp[O_LCP + (b * 3 + 2) * 512 + F.tid] = hu[2];
                }
            } else {
                const int b = ru - BATCH * NCHUNK, row0 = MP + b * DECT;
                const float* cs = in.p[5] + (size_t)b * 3 * 512 + F.tid;
                rnn_segment<true>(F, in, ws, row0, DECT, cs[0], cs[512], cs[1024], in.p[4][b * 512 + F.tid], ra, rb, hu);
                outp[O_LHS + b * 512 + F.tid] = rb;
                outp[O_LCS + (b * 3 + 0) * 512 + F.tid] = hu[0]; outp[O_LCS + (b * 3 + 1) * 512 + F.tid] = hu[1]; outp[O_LCS + (b * 3 + 2) * 512 + F.tid] = hu[2];
            }
        }
    }
    SEAM(5);
    if (IN(6)) {
        pg8::Gemm g{MIXB, (const bf16*)(ws + WS_WOUT), MROWS, DM, DM}; pg8::StaticOrder S; S.init(MROWS, DM, F.G, (int)blockIdx.x);
        pg8::EpiResid<true> E{X1, X1 + (size_t)MP * DM, X2, XB, SS2, 1.0f};
        pg8::gemm_phase<pg8::EpiResid<true>, pg8::StaticOrder, true, true>(F.lds + RING_OFF, g, S, E);
    }
    SEAM(6);
    if (IN(7)) {
        pg8::Gemm g{XB, (const bf16*)(ws + WS_W2GU), MROWS, NGU, DM}; pg8::StaticOrder S; S.init(MROWS, NGU, F.G, (int)blockIdx.x);
        pg8::EpiSwiGLU E{HB, SS2, DFF};
        pg8::gemm_phase<pg8::EpiSwiGLU, pg8::StaticOrder, true, true>(F.lds + RING_OFF, g, S, E);
    }
    SEAM(7);
    if (IN(8)) {
        pg8::Gemm g{HB, (const bf16*)(ws + WS_W2D), MROWS, DM, DFF}; pg8::StaticOrder S; S.init(MROWS, DM, F.G, (int)blockIdx.x);
        pg8::EpiResid<false> E{X2, X2 + (size_t)MP * DM, outp + O_Y, nullptr, SS3, 0.5f};
        pg8::gemm_phase<pg8::EpiResid<false>, pg8::StaticOrder, true, true>(F.lds + RING_OFF, g, S, E);
    }
    SEAM(8);
    if (IN(9)) {
        const int gw = F.vcu * NWAVES + F.wave, NGW = F.G * NWAVES;
        const GAS f32x4* lnf = (const GAS f32x4*)in.p[24] + F.lane;
        f32x4 gn[4];
#pragma unroll
        for (int j = 0; j < 4; ++j) gn[j] = lnf[64 * j];
        for (int m = gw; m < MROWS; m += NGW) {
            const float rs = pg8::row_rs16(SS3, m);
            GAS f32x4* yr = (GAS f32x4*)(outp + O_Y + (size_t)m * DM) + F.lane;
#pragma unroll
            for (int j = 0; j < 4; ++j) { const f32x4 v = yr[64 * j]; yr[64 * j] = v * rs * gn[j]; }
        }
    }
#undef IN
#undef SEAM
}

#ifndef MK_N_LAUNCHES
#define MK_N_LAUNCHES 1
#endif
extern "C" void kernel_launch(void* const* d_in, const int* in_sizes, int n_in, void* d_out, int out_size, void* d_ws, size_t ws_size, hipStream_t stream) {
    static int grid = 0;
    if (grid == 0) {
        if (n_in != 25 || in_sizes[0] != MP * DM || (size_t)out_size != O_END || ws_size < WS_END) { fprintf(stderr, "kernel_launch: unexpected shapes: n_in %d in0 %d out %d ws %zu\n", n_in, n_in > 0 ? in_sizes[0] : -1, out_size, ws_size); grid = -1; return; }
        int dev = 0, cus = 0, per_cu = 0;
        if (hipGetDevice(&dev) != hipSuccess || hipDeviceGetAttribute(&cus, hipDeviceAttributeMultiprocessorCount, dev) != hipSuccess) { grid = -1; return; }
        if (hipFuncSetAttribute((const void*)mega_fwd, hipFuncAttributeMaxDynamicSharedMemorySize, LDS_BYTES) != hipSuccess) { fprintf(stderr, "kernel_launch: hipFuncSetAttribute failed\n"); grid = -1; return; }
        if (hipOccupancyMaxActiveBlocksPerMultiprocessor(&per_cu, (const void*)mega_fwd, NWAVES * 64, LDS_BYTES) != hipSuccess || per_cu < 1) { fprintf(stderr, "kernel_launch: occupancy query says %d\n", per_cu); }
        (void)hipGetLastError();
        grid = cus;
    }
    if (grid < 0) return;
    if (hipMemsetAsync((char*)d_ws + WS_CTL, 0, CTL_ZERO_BYTES, stream) != hipSuccess) return;
    Args a{};
    for (int i = 0; i < 25; ++i) a.in.p[i] = (const float*)d_in[i];
    a.out = (float*)d_out; a.ws = (unsigned char*)d_ws;
#if MK_N_LAUNCHES == 1
    a.ph_lo = 0; a.ph_hi = N_PHASES;
    hipLaunchKernelGGL(mega_fwd, dim3(grid), dim3(NWAVES * 64), LDS_BYTES, stream, a);
#else
    for (int k = 0; k < N_PHASES; ++k) { a.ph_lo = k; a.ph_hi = k + 1; hipLaunchKernelGGL(mega_fwd, dim3(grid), dim3(NWAVES * 64), LDS_BYTES, stream, a); }
#endif
}
```

```cpp
#include <hip/hip_runtime.h>
#include <cstdio>
#include <cstdint>
namespace pg8 {
#define PG8_LAS __attribute__((address_space(3)))
typedef unsigned short bf16_t;
typedef short bf16x8 __attribute__((ext_vector_type(8)));
typedef float f32x4 __attribute__((ext_vector_type(4)));
typedef unsigned u32x4 __attribute__((ext_vector_type(4)));
constexpr int BM = 256, BK = 64, HALF = 128, HTB = HALF * BK * 2  , STAGE_BYTES = 8 * HTB, NXCD = 8, WGM = 8;

__host__ __device__ __forceinline__ int lds_byte(int r, int c) { const int st = (r >> 4) * 2 + (c >> 5), rr = r & 15, cc = c & 31, ob = rr * 64 + cc * 2; return st * 1024 + (ob ^ (((ob >> 9) & 1) << 5)); }
__host__ __device__ __forceinline__ void stage_rc(int b, int& R, int& C) { const int st = b / 1024, sb = b % 1024, swz = sb ^ (((sb >> 9) & 1) << 5); R = (st >> 1) * 16 + swz / 64; C = (st & 1) * 32 + (swz % 64) / 2; }
__host__ __device__ __forceinline__ int perm32(int rho) { const int n = rho >> 4, i = rho & 15; return 8 * (i >> 2) + 4 * n + (i & 3); }

struct Unit { int pm, pn; };
struct Gemm { const bf16_t* A; const bf16_t* Bt; int M, N, K; };

struct StaticOrder {
    int nM, nN, nwg, G, c;
    __host__ __device__ void init(int M, int N, int G_, int c_) { nM = M / BM; nN = N / BM; nwg = nM * nN; G = G_; c = c_; }
    __host__ __device__ bool next(int i, Unit& u) const {
        const long L = (long)i * G + c; if (L >= nwg) return false;
        int wgid = (int)L; { const int q = nwg / NXCD, r = nwg % NXCD, xcd = wgid % NXCD, off = wgid / NXCD; wgid = (xcd < r ? xcd * (q + 1) : r * (q + 1) + (xcd - r) * q) + off; }
        const int nig = WGM * nN, gid = wgid / nig, fm = gid * WGM, gsz = (nM - fm) < WGM ? (nM - fm) : WGM;
        u.pm = fm + ((wgid % nig) % gsz); u.pn = (wgid % nig) / gsz; return true;
    }
    __device__ __forceinline__ void a_ready(const Unit&) const {}
    __device__ __forceinline__ void done(const Unit&) const {}
};
__device__ __forceinline__ unsigned cvt_pk_bf16(float lo, float hi) { unsigned r; asm volatile("v_cvt_pk_bf16_f32 %0, %1, %2" : "=v"(r) : "v"(lo), "v"(hi)); return r; }
typedef float f32x2 __attribute__((ext_vector_type(2)));
constexpr int E_DM = 1024, E_MP = 65536, E_MROWS = 66560;
constexpr size_t E_O_KWP = 68157440, E_O_VWP = 76546048, E_O_KNS = 84951040, E_O_VNS = 85475328;
constexpr float E_QSCALE = 0.125f * 1.4426950408889634f;
typedef unsigned u32x2 __attribute__((ext_vector_type(2)));
__device__ __forceinline__ float row_rs16(const float* ss, int row) {
    const f32x4* p = (const f32x4*)(ss + (size_t)row * 16);
    const f32x4 a = p[0], b = p[1], c = p[2], d = p[3];
    const float s = (((a[0] + a[1]) + (a[2] + a[3])) + ((b[0] + b[1]) + (b[2] + b[3]))) + (((c[0] + c[1]) + (c[2] + c[3])) + ((d[0] + d[1]) + (d[2] + d[3])));
    return __builtin_amdgcn_rsqf(s * (1.0f / 1024.0f) + 1e-6f);
}
__device__ __forceinline__ void rows_to_lds(PG8_LAS float* Rl, const f32x4& pf0, const f32x4& pf1) {
    float s = ((pf0[0] + pf0[1]) + (pf0[2] + pf0[3])) + ((pf1[0] + pf1[1]) + (pf1[2] + pf1[3]));
    s += __builtin_bit_cast(float, __builtin_amdgcn_update_dpp(0, __builtin_bit_cast(int, s), 0xB1, 0xF, 0xF, true));
    if ((threadIdx.x & 1) == 0) Rl[threadIdx.x >> 1] = __builtin_amdgcn_rsqf(s * (1.0f / 1024.0f) + 1e-6f);
    asm volatile("s_waitcnt lgkmcnt(0)\n\ts_barrier" ::: "memory");
}
template <bool RS> struct EpiSwiGLU {
    static constexpr bool PERM = true, AFTER_DRAIN = false, PREFETCH = RS;
    bf16_t* H; const float* ss; int ldh; PG8_LAS float* Rl;
    __device__ __forceinline__ void prefetch(const Unit& u, f32x4& pf0, f32x4& pf1) const {
        const f32x4* p = (const f32x4*)(ss + ((size_t)u.pm * BM + (threadIdx.x >> 1)) * 16 + (threadIdx.x & 1) * 8); pf0 = p[0]; pf1 = p[1];
    }
    __device__ __forceinline__ void operator()(const f32x4 (&acc)[2][2][4][2], const Unit& u, int wr, int wc, int fr, int fq, const f32x4& pf0, const f32x4& pf1) const {
        rows_to_lds(Rl, pf0, pf1);
        run(acc, u, wr, wc, fr, fq);
    }
    __device__ __forceinline__ void operator()(const f32x4 (&acc)[2][2][4][2], const Unit& u, int wr, int wc, int fr, int fq) const { run(acc, u, wr, wc, fr, fq); }
    __device__ __forceinline__ void run(const f32x4 (&acc)[2][2][4][2], const Unit& u, int wr, int wc, int fr, int fq) const {
        typedef float f32x2 __attribute__((ext_vector_type(2)));
        const int row0 = u.pm * BM + wr * 64 + fr, col0 = u.pn * HALF + wc * 32 + 8 * fq;
#pragma unroll
        for (int ai = 0; ai < 2; ++ai) {
            float rs[4];
#pragma unroll
            for (int m = 0; m < 4; ++m) rs[m] = RS ? Rl[ai * HALF + wr * 64 + m * 16 + fr] : 1.0f;
#pragma unroll
            for (int m = 0; m < 4; ++m) {
                const int row = row0 + ai * HALF + m * 16;
                f32x2 hv[4];
#pragma unroll
                for (int n = 0; n < 2; ++n)
#pragma unroll
                    for (int e = 0; e < 2; ++e) {
                        f32x2 t = (f32x2){acc[ai][0][m][n][2 * e], acc[ai][0][m][n][2 * e + 1]};
                        f32x2 p = (f32x2){acc[ai][1][m][n][2 * e], acc[ai][1][m][n][2 * e + 1]};
                        if (RS) { t = t * rs[m]; p = p * rs[m]; }
                        p = p * t;
                        f32x2 d; d.x = __builtin_amdgcn_exp2f(t.x); d.y = __builtin_amdgcn_exp2f(t.y);
                        d = d + 1.0f;
                        f32x2 r; r.x = __builtin_amdgcn_rcpf(d.x); r.y = __builtin_amdgcn_rcpf(d.y);
                        hv[n * 2 + e] = p * r;
                    }
                u32x4 w; w.x = cvt_pk_bf16(hv[0].x, hv[0].y); w.y = cvt_pk_bf16(hv[1].x, hv[1].y); w.z = cvt_pk_bf16(hv[2].x, hv[2].y); w.w = cvt_pk_bf16(hv[3].x, hv[3].y);
                *(u32x4*)(H + (size_t)row * ldh + col0) = w;
            }
        }
    }
};
template <bool BB, bool OF, bool OB, bool PT> struct EpiResid {
    static constexpr bool PERM = true, AFTER_DRAIN = false, PREFETCH = false;
    const float* base; const float* ri; float* outf; bf16_t* xb; float* ss; PG8_LAS float* T; float alpha;
    __device__ __forceinline__ void operator()(const f32x4 (&acc)[2][2][4][2], const Unit& u, int wr, int wc, int fr_, int fq_) const {
        int fr = fr_, fq = fq_; asm volatile("" : "+v"(fr), "+v"(fq));
        const int row0 = u.pm * BM + wr * 64 + fr, col0 = u.pn * BM + wc * 32 + 8 * fq;
#pragma unroll
        for (int ai = 0; ai < 2; ++ai) {
            u32x4 praw[BB ? 4 : 1][2]; f32x4 pre[BB ? 1 : 4][2][2]; float rinv[4];
#pragma unroll
            for (int m = 0; m < 4; ++m) {
                rinv[m] = (BB && ri) ? ri[row0 + ai * HALF + m * 16] : 1.0f;
#pragma unroll
                for (int bj = 0; bj < 2; ++bj) {
                    const size_t off = (size_t)(row0 + ai * HALF + m * 16) * E_DM + col0 + bj * HALF;
                    if (BB) praw[m][bj] = *(const u32x4*)(xb + off);
                    else { pre[m][bj][0] = *(const f32x4*)(base + off); pre[m][bj][1] = *(const f32x4*)(base + off + 4); }
                }
            }
            if (BB) asm volatile("" ::: "memory");
#pragma unroll
            for (int m = 0; m < 4; ++m) {
                const int row = row0 + ai * HALF + m * 16; float q = 0.f;
#pragma unroll
                for (int bj = 0; bj < 2; ++bj) {
                    const size_t off = (size_t)row * E_DM + col0 + bj * HALF;
                    f32x4 b0, b1;
                    if (BB) { const u32x4 w = praw[BB ? m : 0][bj];
                        b0 = (f32x4){__builtin_bit_cast(float, w.x << 16), __builtin_bit_cast(float, w.x & 0xffff0000u), __builtin_bit_cast(float, w.y << 16), __builtin_bit_cast(float, w.y & 0xffff0000u)} * rinv[m];
                        b1 = (f32x4){__builtin_bit_cast(float, w.z << 16), __builtin_bit_cast(float, w.z & 0xffff0000u), __builtin_bit_cast(float, w.w << 16), __builtin_bit_cast(float, w.w & 0xffff0000u)} * rinv[m]; }
                    else { b0 = pre[BB ? 0 : m][bj][0]; b1 = pre[BB ? 0 : m][bj][1]; }
                    const f32x4 o0 = b0 + acc[ai][bj][m][0] * alpha, o1 = b1 + acc[ai][bj][m][1] * alpha;
                    if (OF) { *(f32x4*)(outf + off) = o0; *(f32x4*)(outf + off + 4) = o1; }
                    q += ((o0[0] * o0[0] + o0[1] * o0[1]) + (o0[2] * o0[2] + o0[3] * o0[3])) + ((o1[0] * o1[0] + o1[1] * o1[1]) + (o1[2] * o1[2] + o1[3] * o1[3]));
                    if (OB) { u32x4 w; w.x = cvt_pk_bf16(o0[0], o0[1]); w.y = cvt_pk_bf16(o0[2], o0[3]); w.z = cvt_pk_bf16(o1[0], o1[1]); w.w = cvt_pk_bf16(o1[2], o1[3]); *(u32x4*)(xb + off) = w; }
                }
                q += __shfl_xor(q, 16); q += __shfl_xor(q, 32);
                if (fq == 0) ss[(size_t)row * 16 + u.pn * 4 + wc] = q;
            }
        }
    }
};
struct EpiZ {
    static constexpr bool PERM = true, AFTER_DRAIN = false, PREFETCH = true;
    bf16_t* Z; const float* ss; float* outp; PG8_LAS float* Rl;
    __device__ __forceinline__ void prefetch(const Unit& u, f32x4& pf0, f32x4& pf1) const {
        const f32x4* p = (const f32x4*)(ss + ((size_t)u.pm * BM + (threadIdx.x >> 1)) * 16 + (threadIdx.x & 1) * 8); pf0 = p[0]; pf1 = p[1];
    }
    __device__ __forceinline__ void operator()(const f32x4 (&acc)[2][2][4][2], const Unit& u, int wr, int wc, int fr, int fq, const f32x4& pf0, const f32x4& pf1) const {
        rows_to_lds(Rl, pf0, pf1);
        const int t = u.pn >> 1, colt = (u.pn & 1) * BM;
        bf16_t* zb = Z + (size_t)t * ((size_t)E_MROWS * 512);
        const float sc = (t == 0) ? E_QSCALE : 1.0f;
        const int row0 = u.pm * BM + wr * 64 + fr, col0 = colt + wc * 32 + 8 * fq;
        const bool wout = (t == 1 || t == 2) && (u.pm >= 256 || (u.pm & 31) >= 24);
#pragma unroll
        for (int ai = 0; ai < 2; ++ai) {
            float rs[4];
#pragma unroll
            for (int m = 0; m < 4; ++m) rs[m] = Rl[ai * HALF + wr * 64 + m * 16 + fr] * sc;
#pragma unroll
            for (int m = 0; m < 4; ++m) {
                const int row = row0 + ai * HALF + m * 16;
                size_t oo = 0;
                if (wout) { if (row < E_MP) oo = (t == 1 ? E_O_KWP : E_O_VWP) + ((size_t)((row >> 13) * 2048 + (row & 8191) - 6144)) * 512; else oo = (t == 1 ? E_O_KNS : E_O_VNS) + (size_t)(row - E_MP) * 512; }
#pragma unroll
                for (int bj = 0; bj < 2; ++bj) {
                    const f32x4 v0 = acc[ai][bj][m][0] * rs[m], v1 = acc[ai][bj][m][1] * rs[m];
                    u32x4 w; w.x = cvt_pk_bf16(v0[0], v0[1]); w.y = cvt_pk_bf16(v0[2], v0[3]); w.z = cvt_pk_bf16(v1[0], v1[1]); w.w = cvt_pk_bf16(v1[2], v1[3]);
                    if (t == 1 || t == 2) {
                        if (row < E_MP) { const int cc = col0 + bj * HALF; *(u32x4*)(zb + ((((size_t)(row >> 13) * 8 + (cc >> 6)) * 16 + (row & 15)) * 512 + ((row & 8191) >> 4)) * 64 + (cc & 63)) = w; }
                    } else *(u32x4*)(zb + (size_t)row * 512 + col0 + bj * HALF) = w;
                    if (wout) { float* op = outp + oo + col0 + bj * HALF; *(f32x4*)op = v0; *(f32x4*)(op + 4) = v1; }
                }
            }
        }
    }
};

template <class Epi, class Sched, bool ALIGN_EPI = false, bool SP2 = false>
__device__ __forceinline__ void gemm_phase(PG8_LAS unsigned char* lds, const Gemm g, const Sched& S, const Epi& E) {
    const int tid = threadIdx.x, wid = __builtin_amdgcn_readfirstlane(tid >> 6), lane = tid & 63, wr = wid >> 2, wc = wid & 3, fr = lane & 15, fq = lane >> 4;
    const int K = g.K, nt = K / BK;
    unsigned voffA[2], voffB[2];
#pragma unroll
    for (int i = 0; i < 2; ++i) { int R, C; stage_rc(tid * 16 + i * 8192, R, C); const int Rb = Epi::PERM ? ((R & ~31) + perm32(R & 31)) : R;
        voffA[i] = (unsigned)(R * K + C) * 2u; voffB[i] = (unsigned)(Rb * K + C) * 2u; }
    const size_t kstep = (size_t)(BK * 2);
    const size_t hstep = (size_t)HALF * K * 2;
    const size_t tstep = 2 * hstep;
    const unsigned ldsw = (unsigned)wid * 1024u;
    const int aoff = lds_byte(wr * 64 + fr, fq * 8), boff = lds_byte(wc * 32 + fr, fq * 8);
#define PG8_SA(b, h) (((b) * 2 + (h)) * HTB)
#define PG8_SB(b, h) ((4 + (b) * 2 + (h)) * HTB)
#define PG8_STAGE(bufoff, gbase, voff) do { _Pragma("unroll") for (int _i = 0; _i < 2; ++_i) \
        __builtin_amdgcn_global_load_lds((const unsigned*)((const char*)(gbase) + (voff)[_i]), (PG8_LAS unsigned*)(lds + (bufoff) + ldsw + _i * 8192), 16, 0, 0); } while (0)
#define PG8_LDA(dst, b, h) do { _Pragma("unroll") for (int m = 0; m < 4; ++m) _Pragma("unroll") for (int k = 0; k < 2; ++k) dst[m][k] = *(const PG8_LAS bf16x8*)(lds + PG8_SA(b, h) + aoff + m * 2048 + k * 1024); } while (0)
#define PG8_LDB(dst, b, h) do { _Pragma("unroll") for (int n = 0; n < 2; ++n) _Pragma("unroll") for (int k = 0; k < 2; ++k) dst[n][k] = *(const PG8_LAS bf16x8*)(lds + PG8_SB(b, h) + boff + n * 2048 + k * 1024); } while (0)
#define PG8_MMA(ai, bj, At, Bt) do { __builtin_amdgcn_s_setprio(1); _Pragma("unroll") for (int m = 0; m < 4; ++m) _Pragma("unroll") for (int n = 0; n < 2; ++n) _Pragma("unroll") for (int k = 0; k < 2; ++k) \
        acc[ai][bj][m][n] = __builtin_amdgcn_mfma_f32_16x16x32_bf16(Bt[n][k], At[m][k], acc[ai][bj][m][n], 0, 0, 0); __builtin_amdgcn_s_setprio(0); } while (0)
#define PG8_WAIT_V(n) asm volatile("s_waitcnt vmcnt(" #n ")" ::: "memory")
#define PG8_WAIT_L(n) asm volatile("s_waitcnt lgkmcnt(" #n ")" ::: "memory")
#define PG8_BAR __builtin_amdgcn_s_barrier()
#define PG8_SCHED __builtin_amdgcn_sched_barrier(0)
    Unit cur, nxt; int ui = 0;
    if (!S.next(0, cur)) return;
    f32x4 acc[2][2][4][2];
    f32x4 pf0 = (f32x4){0.f, 0.f, 0.f, 0.f}, pf1 = pf0;
#pragma unroll
    for (int a = 0; a < 2; ++a)
#pragma unroll
        for (int b = 0; b < 2; ++b)
#pragma unroll
            for (int m = 0; m < 4; ++m)
#pragma unroll
                for (int n = 0; n < 2; ++n) acc[a][b][m][n] = (f32x4){0.f, 0.f, 0.f, 0.f};
    bf16x8 At[4][2], B0[2][2], B1[2][2];
    const char* cA = (const char*)g.A + (size_t)cur.pm * tstep; const char* cB = (const char*)g.Bt + (size_t)cur.pn * tstep;
    S.a_ready(cur);
    if constexpr (SP2) {
        PG8_STAGE(PG8_SB(0, 0), cB, voffB); PG8_STAGE(PG8_SB(0, 1), cB + hstep, voffB); PG8_STAGE(PG8_SA(0, 0), cA, voffA); PG8_STAGE(PG8_SA(0, 1), cA + hstep, voffA);
        if (wr == 1) PG8_BAR;
        PG8_WAIT_V(2); PG8_BAR;
        PG8_STAGE(PG8_SB(1, 0), cB + kstep, voffB); PG8_STAGE(PG8_SA(1, 0), cA + kstep, voffA); PG8_STAGE(PG8_SB(1, 1), cB + hstep + kstep, voffB);
        PG8_WAIT_V(6); PG8_BAR;
    } else {
        PG8_STAGE(PG8_SB(0, 0), cB, voffB); PG8_STAGE(PG8_SA(0, 0), cA, voffA); PG8_STAGE(PG8_SB(0, 1), cB + hstep, voffB); PG8_STAGE(PG8_SA(0, 1), cA + hstep, voffA);
        if (wr == 1) PG8_BAR;
        PG8_WAIT_V(4); PG8_BAR;
        PG8_STAGE(PG8_SB(1, 0), cB + kstep, voffB); PG8_STAGE(PG8_SA(1, 0), cA + kstep, voffA); PG8_STAGE(PG8_SB(1, 1), cB + hstep + kstep, voffB);
        PG8_WAIT_V(6); PG8_BAR;
    }
    for (;;) {
        const bool has_next = S.next(ui + 1, nxt);
        const char* nA = has_next ? (const char*)g.A + (size_t)nxt.pm * tstep : cA; const char* nB = has_next ? (const char*)g.Bt + (size_t)nxt.pn * tstep : cB;
        for (int t = 0; t < nt; t += 2) {
            const bool last = (t == nt - 2);
            const char* a1 = cA + (size_t)(t + 1) * kstep;
            const char* a2 = last ? nA : cA + (size_t)(t + 2) * kstep; const char* b2 = last ? nB : cB + (size_t)(t + 2) * kstep;
            const char* a3 = a2 + kstep; const char* b3 = b2 + kstep;
            if (last && has_next) S.a_ready(nxt);
            if constexpr (Epi::PREFETCH) { if (last) E.prefetch(cur, pf0, pf1); }
            if constexpr (SP2) {
            PG8_LDB(B0, 0, 0); PG8_LDB(B1, 0, 1); PG8_SCHED; PG8_LDA(At, 0, 0); PG8_STAGE(PG8_SA(1, 1), a1 + hstep, voffA);
            PG8_WAIT_V(8); PG8_WAIT_L(0); PG8_BAR; PG8_MMA(0, 0, At, B0); PG8_MMA(0, 1, At, B1); PG8_BAR; PG8_SCHED;
            PG8_LDA(At, 0, 1); PG8_STAGE(PG8_SB(0, 0), b2, voffB); PG8_STAGE(PG8_SB(0, 1), b2 + hstep, voffB); PG8_STAGE(PG8_SA(0, 0), a2, voffA);
            PG8_WAIT_V(8); PG8_WAIT_L(0); PG8_BAR; PG8_MMA(1, 0, At, B0); PG8_MMA(1, 1, At, B1); PG8_BAR; PG8_SCHED;
            PG8_LDB(B0, 1, 0); PG8_LDB(B1, 1, 1); PG8_SCHED; PG8_LDA(At, 1, 0); PG8_STAGE(PG8_SA(0, 1), a2 + hstep, voffA);
            PG8_WAIT_V(8); PG8_WAIT_L(0); PG8_BAR; PG8_MMA(0, 0, At, B0); PG8_MMA(0, 1, At, B1); PG8_BAR; PG8_SCHED;
            PG8_LDA(At, 1, 1); PG8_STAGE(PG8_SB(1, 0), b3, voffB); PG8_STAGE(PG8_SB(1, 1), b3 + hstep, voffB); PG8_STAGE(PG8_SA(1, 0), a3, voffA);
            PG8_WAIT_V(8); PG8_WAIT_L(0); PG8_BAR; PG8_MMA(1, 0, At, B0); PG8_MMA(1, 1, At, B1); PG8_BAR; PG8_SCHED;
            } else {
            PG8_LDB(B0, 0, 0); PG8_SCHED; PG8_LDA(At, 0, 0); PG8_STAGE(PG8_SA(1, 1), a1 + hstep, voffA);
            PG8_WAIT_L(8); PG8_BAR; PG8_WAIT_L(0); PG8_MMA(0, 0, At, B0); PG8_BAR; PG8_SCHED;
            PG8_LDB(B1, 0, 1); PG8_STAGE(PG8_SB(0, 0), b2, voffB);
            PG8_BAR; PG8_WAIT_L(0); PG8_MMA(0, 1, At, B1); PG8_BAR;
            PG8_LDA(At, 0, 1); PG8_STAGE(PG8_SA(0, 0), a2, voffA);
            PG8_BAR; PG8_WAIT_L(0); PG8_MMA(1, 0, At, B0); PG8_BAR; PG8_SCHED;
            PG8_STAGE(PG8_SB(0, 1), b2 + hstep, voffB);
            PG8_WAIT_V(6); PG8_BAR; PG8_MMA(1, 1, At, B1); PG8_BAR;
            PG8_LDB(B0, 1, 0); PG8_SCHED; PG8_LDA(At, 1, 0); PG8_STAGE(PG8_SA(0, 1), a2 + hstep, voffA);
            PG8_WAIT_L(8); PG8_BAR; PG8_WAIT_L(0); PG8_MMA(0, 0, At, B0); PG8_BAR; PG8_SCHED;
            PG8_LDB(B1, 1, 1); PG8_STAGE(PG8_SB(1, 0), b3, voffB);
            PG8_BAR; PG8_WAIT_L(0); PG8_MMA(0, 1, At, B1); PG8_BAR;
            PG8_LDA(At, 1, 1); PG8_STAGE(PG8_SA(1, 0), a3, voffA);
            PG8_BAR; PG8_WAIT_L(0); PG8_MMA(1, 0, At, B0); PG8_BAR; PG8_SCHED;
            PG8_STAGE(PG8_SB(1, 1), b3 + hstep, voffB);
            PG8_WAIT_V(6); PG8_BAR; PG8_MMA(1, 1, At, B1); PG8_BAR;
            }
        }
        if constexpr (ALIGN_EPI) { if (wr == 0) PG8_BAR; }
        if constexpr (!Epi::AFTER_DRAIN) { if constexpr (Epi::PREFETCH) E(acc, cur, wr, wc, fr, fq, pf0, pf1); else E(acc, cur, wr, wc, fr, fq); S.done(cur); }
        if (!has_next) break;
#pragma unroll
        for (int a = 0; a < 2; ++a)
#pragma unroll
            for (int b = 0; b < 2; ++b)
#pragma unroll
                for (int m = 0; m < 4; ++m)
#pragma unroll
                    for (int n = 0; n < 2; ++n) acc[a][b][m][n] = (f32x4){0.f, 0.f, 0.f, 0.f};
        cur = nxt; cA = nA; cB = nB; ++ui;
        if constexpr (ALIGN_EPI) { if (wr == 1) PG8_BAR; }
    }
    PG8_WAIT_V(0);
    if constexpr (!ALIGN_EPI) { if (wr == 0) PG8_BAR; }
    PG8_BAR;
    if constexpr (Epi::AFTER_DRAIN) { E.fused(acc, cur, wr, wc, fr, fq, lds, wid, lane); S.done(cur); }
#undef PG8_SA
#undef PG8_SB
#undef PG8_STAGE
#undef PG8_LDA
#undef PG8_LDB
#undef PG8_MMA
#undef PG8_WAIT_V
#undef PG8_WAIT_L
#undef PG8_BAR
#undef PG8_SCHED
}
}
#define GAS __attribute__((address_space(1)))
#define LAS __attribute__((address_space(3)))
typedef unsigned short bf16;
typedef unsigned v4u __attribute__((ext_vector_type(4)));
typedef float f32x4 __attribute__((ext_vector_type(4)));
typedef short bf16x8 __attribute__((ext_vector_type(8)));
typedef GAS unsigned gu32;
typedef GAS unsigned long long gu64;
#define RLX_AGENT __ATOMIC_RELAXED, __HIP_MEMORY_SCOPE_AGENT
#define LDS_WAIT() asm volatile("s_waitcnt lgkmcnt(0)" ::: "memory")
#define VM_WAIT() asm volatile("s_waitcnt vmcnt(0)" ::: "memory")
__device__ __forceinline__ unsigned long long rt() { return __builtin_amdgcn_s_memrealtime(); }
__device__ __forceinline__ unsigned f2bf(float f) { unsigned u = __builtin_bit_cast(unsigned, f); return (u + 0x7fffu + ((u >> 16) & 1u)) >> 16; }
__device__ __forceinline__ unsigned pk2(float lo, float hi) { return f2bf(lo) | (f2bf(hi) << 16); }

#define XB_TMO      128
#define XB_XCNT(j)  (256  + 64 * (j))
#define XB_XSUB(j)  (1280 + 64 * (j))
#define XB_XGEN(j)  (2304 + 64 * (j))
#define XB_TOP      3328
#define XB_TOPGEN   3392
#define XCD_BAR_WORDS 3456
#define XB_SPIN_CAP (1u << 18)

__device__ __forceinline__ unsigned xb_ld(unsigned* p)              { return __hip_atomic_load(p, __ATOMIC_RELAXED, __HIP_MEMORY_SCOPE_AGENT); }
__device__ __forceinline__ unsigned xb_add(unsigned* p, unsigned v) { return __hip_atomic_fetch_add(p, v, __ATOMIC_RELAXED, __HIP_MEMORY_SCOPE_AGENT); }
__device__ __forceinline__ unsigned xb_xcc_id() { return (unsigned)__builtin_amdgcn_s_getreg((3 << 11) | 20) & 0xFu; }
#define XB_SPIN(cond, bar) do { unsigned _sp = 0; while (cond) { __builtin_amdgcn_s_sleep(1); \
    if ((++_sp & 255u) == 0u) { if (xb_ld(&(bar)[XB_TMO])) break; if (_sp > XB_SPIN_CAP) { atomicAdd(&(bar)[XB_TMO], 1u); break; } } } } while (0)

struct XcdBarrier {
    unsigned* bar; unsigned x;
    volatile LAS unsigned* st;
};

__device__ __forceinline__ XcdBarrier xcd_barrier_post(unsigned* bar, volatile LAS unsigned* st) {
    XcdBarrier b; b.bar = bar; b.x = xb_xcc_id(); b.st = st;
    if (threadIdx.x == 0) (void)xb_add(&bar[XB_XCNT(b.x)], 1u);
    return b;
}
__device__ __forceinline__ void xcd_barrier_complete(unsigned* bar, unsigned x, unsigned& nloc, unsigned& nx) {
    const unsigned G = gridDim.x * gridDim.y * gridDim.z;
    unsigned sum, cnt, mine, sp = 0u;
    for (;;) {
        sum = 0u; cnt = 0u; mine = 0u;
#pragma unroll
        for (unsigned j = 0; j < 16; ++j) { const unsigned c = xb_ld(&bar[XB_XCNT(j)]); sum += c; cnt += (c > 0u) ? 1u : 0u; mine = (j == x) ? c : mine; }
        if (sum == G) break;
        __builtin_amdgcn_s_sleep(1);
        if ((++sp & 255u) == 0u) { if (xb_ld(&bar[XB_TMO])) break; if (sp > XB_SPIN_CAP) { atomicAdd(&bar[XB_TMO], 1u); break; } }
    }
    nloc = mine > 0u ? mine : 1u; nx = cnt > 0u ? cnt : 1u;
}

__device__ __forceinline__ void xcd_barrier(const XcdBarrier& b) {
    asm volatile("s_waitcnt vmcnt(0)" ::: "memory");
    __syncthreads();
    if (threadIdx.x == 0) {
        unsigned* bar = b.bar;
        __builtin_amdgcn_s_waitcnt(0);
        unsigned nloc = b.st[0], nx = b.st[1];
        if (nloc == 0u) { xcd_barrier_complete(bar, b.x, nloc, nx); b.st[0] = nloc; b.st[1] = nx; }
        const unsigned old = xb_add(&bar[XB_XSUB(b.x)], 1u);
        const unsigned gen = old / nloc;
        if (old + 1u == (gen + 1u) * nloc) {
            __builtin_amdgcn_fence(__ATOMIC_RELEASE, "agent");
            asm volatile("s_waitcnt vmcnt(0)" ::: "memory");
            const unsigned og = xb_add(&bar[XB_TOP], 1u);
            const unsigned tg = og / nx;
            if (og + 1u == (tg + 1u) * nx) xb_add(&bar[XB_TOPGEN], 1u);
            else XB_SPIN(xb_ld(&bar[XB_TOPGEN]) == tg, bar);
            __builtin_amdgcn_fence(__ATOMIC_ACQUIRE, "agent");
            xb_add(&bar[XB_XGEN(b.x)], 1u);
            asm volatile("s_waitcnt vmcnt(0)" ::: "memory");
        } else {
            XB_SPIN(xb_ld(&bar[XB_XGEN(b.x)]) == gen, bar);
            __builtin_amdgcn_fence(__ATOMIC_ACQUIRE, "agent");
            asm volatile("s_waitcnt vmcnt(0)" ::: "memory");
        }
    }
    __syncthreads();
}

constexpr int NWAVES = 8;
constexpr int DM = 1024, DFF = 2816, NHEAD = 8, HD = 64, DATT = 512, DRNN = 512;
constexpr int BATCH = 8, SEQ = 8192, DECB = 128, DECT = 8, WBUF = 2048;
constexpr int MP = BATCH * SEQ, MS = DECB * DECT, MROWS = MP + MS;
constexpr int NGU = 2 * DFF, NIN = 3 * DATT + 2 * DRNN;
constexpr int NCHUNK = SEQ / 256;
static_assert(MROWS % 256 == 0 && MROWS == pg8::E_MROWS && MP == pg8::E_MP && DM == pg8::E_DM, "shapes");
constexpr size_t O_Y = 0, O_KWP = 68157440, O_VWP = 76546048, O_LHP = 84934656, O_LCP = 84938752, O_KNS = 84951040, O_VNS = 85475328, O_LHS = 85999616, O_LCS = 86065152, O_END = 86261760;
static_assert(O_KWP == pg8::E_O_KWP && O_VWP == pg8::E_O_VWP && O_KNS == pg8::E_O_KNS && O_VNS == pg8::E_O_VNS, "offsets");
constexpr size_t MiB = 1u << 20;
constexpr size_t WS_CTL = 0, CTL_ZERO_BYTES = 1 * MiB;
constexpr size_t WS_W1GU = 2 * MiB, WS_W1D = 13 * MiB, WS_WIN = 19 * MiB, WS_WOUT = 24 * MiB, WS_W2GU = 26 * MiB, WS_W2D = 37 * MiB, WS_WGA = 43 * MiB, WS_WGX = 43 * MiB + 65536;
constexpr size_t WS_SS0 = 44 * MiB  , WS_SS1 = 49 * MiB, WS_SS2 = 54 * MiB, WS_SS3 = 59 * MiB;
constexpr size_t WS_RSA = 64 * MiB, WS_RSB = 64 * MiB + 524288;
constexpr size_t WS_RI0 = 65 * MiB;
constexpr size_t WS_PL = 66 * MiB;
constexpr size_t WS_XB = 128 * MiB;
constexpr size_t WS_H = 258 * MiB;
constexpr size_t WS_PO = 258 * MiB;
constexpr size_t WS_Z = 616 * MiB;
constexpr size_t WS_MIX = 941 * MiB;
constexpr size_t WS_END = 1072 * MiB;
constexpr int CW_BAR = 4096;
constexpr int RING_OFF = 0, RING_BYTES = 131072;
constexpr int QBUF_OFF = RING_BYTES, QBUF_BYTES = 16384;
constexpr int WARM_OFF = QBUF_OFF + QBUF_BYTES, WARM_BYTES = 2048;
constexpr int LDSCTL_OFF = WARM_OFF + WARM_BYTES, MISC_OFF = LDSCTL_OFF + 320;
constexpr int LDS_BYTES = 150528;

struct Frame {
    LAS unsigned char* lds;
    volatile LAS unsigned* MISC;
    gu32* ctl;
    int tid, lane, wave;
    int vcu, G;
};

__device__ __forceinline__ float wave_sum(float v) {
#pragma unroll
    for (int o = 1; o < 64; o <<= 1) v += __shfl_xor(v, o);
    return v;
}
__device__ __forceinline__ float bf2f(unsigned short b) { return __builtin_bit_cast(float, (unsigned)b << 16); }
__device__ __forceinline__ float fsigmoid(float x) { return __builtin_amdgcn_rcpf(1.0f + __builtin_amdgcn_exp2f(-1.4426950408889634f * x)); }

template <int CTRL> __device__ __forceinline__ float dppmov(float v) { return __builtin_bit_cast(float, __builtin_amdgcn_update_dpp(0, __builtin_bit_cast(int, v), CTRL, 0xF, 0xF, true)); }
__device__ __forceinline__ float sum16(float v) {
    v += dppmov<0xB1>(v); v += dppmov<0x4E>(v); v += dppmov<0x141>(v); v += dppmov<0x140>(v); return v;
}
__device__ __forceinline__ float rows_max(float v) {
    { auto rr = __builtin_amdgcn_permlane16_swap(__float_as_uint(v), __float_as_uint(v), false, false); v = fmaxf(__uint_as_float(rr[0]), __uint_as_float(rr[1])); }
    { auto rr = __builtin_amdgcn_permlane32_swap(__float_as_uint(v), __float_as_uint(v), false, false); v = fmaxf(__uint_as_float(rr[0]), __uint_as_float(rr[1])); }
    return v;
}
__device__ __forceinline__ float rows_sum(float v) {
    { auto rr = __builtin_amdgcn_permlane16_swap(__float_as_uint(v), __float_as_uint(v), false, false); v = __uint_as_float(rr[0]) + __uint_as_float(rr[1]); }
    { auto rr = __builtin_amdgcn_permlane32_swap(__float_as_uint(v), __float_as_uint(v), false, false); v = __uint_as_float(rr[0]) + __uint_as_float(rr[1]); }
    return v;
}

__device__ __forceinline__ void p0_transpose_item(const float* W, int ldw, const float* ksc, int k0, int n0, bf16* WT, int K, int dst_row0, LAS float* scr, int lane, float kmul = 1.0f) {
    float wv[32], wsc[32];
#pragma unroll
    for (int i = 0; i < 32; ++i) { const int kk = 2 * i + (lane >> 5); wv[i] = W[(size_t)(k0 + kk) * ldw + n0 + (lane & 31)]; wsc[i] = ksc ? ksc[k0 + kk] * kmul : kmul; }
#pragma unroll
    for (int i = 0; i < 32; ++i) { const int kk = 2 * i + (lane >> 5); scr[kk * 33 + (lane & 31)] = wv[i] * wsc[i]; }
    LDS_WAIT(); asm volatile("" ::: "memory");
    const int c = lane & 7;
#pragma unroll
    for (int j = 0; j < 4; ++j) { const int n = (lane >> 3) + 8 * j; const LAS float* s = scr + (8 * c) * 33 + n;
        v4u o; o.x = pk2(s[0 * 33], s[1 * 33]); o.y = pk2(s[2 * 33], s[3 * 33]); o.z = pk2(s[4 * 33], s[5 * 33]); o.w = pk2(s[6 * 33], s[7 * 33]);
        *(GAS v4u*)(WT + (size_t)(dst_row0 + n) * K + k0 + 8 * c) = o; }
    LDS_WAIT(); asm volatile("" ::: "memory");
}
struct In { const float* p[25]; };
__device__ __forceinline__ void p0_prologue(Frame& F, const In& in, unsigned char* ws) {
    LAS float* scr = (LAS float*)(F.lds + RING_OFF + F.wave * 16384);
    const int gw = F.vcu * NWAVES + F.wave, NGW = F.G * NWAVES;
    constexpr int I_GU = (DM / 64) * (DFF / 32), I_D = (DFF / 64) * (DM / 32), I_IN = (DM / 64) * (NIN / 32), I_O = (DM / 64) * (DM / 32);
    constexpr int NITEMS = 4 * I_GU + 2 * I_D + I_IN + I_O;
    for (int it = gw; it < NITEMS; it += NGW) {
        int r = it;
        if (r < 4 * I_GU) {
            const int which = r / I_GU; r -= which * I_GU;
            const int nb = r % (DFF / 32), kb = r / (DFF / 32), n0 = 32 * nb;
            const float* W = in.p[which == 0 ? 7 : which == 1 ? 8 : which == 2 ? 21 : 22];
            const float* ln = in.p[which < 2 ? 6 : 20];
            bf16* WT = (bf16*)(ws + (which < 2 ? WS_W1GU : WS_W2GU));
            p0_transpose_item(W, DFF, ln, 64 * kb, n0, WT, DM, (n0 / 128) * 256 + (n0 % 128) + ((which & 1) ? 128 : 0), scr, F.lane, (which & 1) ? -0.6931471805599453f : -1.4426950408889634f);
            continue;
        }
        r -= 4 * I_GU;
        if (r < 2 * I_D) {
            const int which = r / I_D; r -= which * I_D;
            const int nb = r % (DM / 32), kb = r / (DM / 32);
            p0_transpose_item(in.p[which == 0 ? 9 : 23], DM, nullptr, 64 * kb, 32 * nb, (bf16*)(ws + (which == 0 ? WS_W1D : WS_W2D)), DFF, 32 * nb, scr, F.lane);
            continue;
        }
        r -= 2 * I_D;
        if (r < I_IN) { const int nb = r % (NIN / 32), kb = r / (NIN / 32); p0_transpose_item(in.p[11], NIN, in.p[10], 64 * kb, 32 * nb, (bf16*)(ws + WS_WIN), DM, 32 * nb, scr, F.lane); continue; }
        r -= I_IN;
        { const int nb = r % (DM / 32), kb = r / (DM / 32); p0_transpose_item(in.p[19], DM, nullptr, 64 * kb, 32 * nb, (bf16*)(ws + WS_WOUT), DM, 32 * nb, scr, F.lane); }
    }
    for (int e = (F.vcu * NWAVES + F.wave) * 64 + F.lane; e < 2 * 32768; e += NGW * 64) {
        const int which = e >> 15, r = e & 32767, n = r >> 12, d = (r >> 6) & 63, c = r & 63;
        const float v = in.p[which ? 16 : 14][(n * 64 + c) * 64 + d];
        ((bf16*)(ws + (which ? WS_WGX : WS_WGA)))[r] = (bf16)f2bf(v);
    }
    bf16* XB = (bf16*)(ws + WS_XB); float* RI0 = (float*)(ws + WS_RI0);
    for (int m0 = gw; m0 < MROWS; m0 += 8 * NGW) {
        f32x4 v[8][4];
#pragma unroll
        for (int r = 0; r < 8; ++r) {
            const int m = (m0 + r * NGW < MROWS) ? m0 + r * NGW : m0;
            const float* xrow = (m < MP) ? in.p[0] + (size_t)m * DM : in.p[1] + (size_t)(m - MP) * DM;
            const GAS f32x4* xr = (const GAS f32x4*)xrow + F.lane;
#pragma unroll
            for (int j = 0; j < 4; ++j) v[r][j] = xr[64 * j];
        }
#pragma unroll
        for (int r = 0; r < 8; ++r) {
            const int m = m0 + r * NGW;
            float s = 0.f;
#pragma unroll
            for (int j = 0; j < 4; ++j) s += (v[r][j].x * v[r][j].x + v[r][j].y * v[r][j].y) + (v[r][j].z * v[r][j].z + v[r][j].w * v[r][j].w);
            s = rows_sum(sum16(s));
            const float ms = s * (1.0f / DM) + 1e-6f, rs = __builtin_amdgcn_rsqf(ms);
            if (m < MROWS) {
                GAS unsigned long long* o8 = (GAS unsigned long long*)(XB + (size_t)m * DM) + F.lane;
#pragma unroll
                for (int j = 0; j < 4; ++j) o8[64 * j] = (unsigned long long)pk2(v[r][j].x * rs, v[r][j].y * rs) | ((unsigned long long)pk2(v[r][j].z * rs, v[r][j].w * rs) << 32);
                if (F.lane == 0) RI0[m] = ms * rs;
            }
        }
    }
}

typedef short v4i16_t __attribute__((ext_vector_type(4)));
typedef unsigned u32x2_t __attribute__((ext_vector_type(2)));
__device__ __forceinline__ v4i16_t vtr(const LAS unsigned char* p) { return __builtin_amdgcn_ds_read_tr16_b64_v4i16((LAS v4i16_t*)p); }
constexpr int ATT_V = 32768, ATT_BUF = 65536;
__device__ __forceinline__ void glds16(const void* gsrc, unsigned lds_dst) {
    unsigned keep;
    asm volatile("s_mov_b32 %0, m0\n\ts_mov_b32 m0, %2\n\ts_nop 0\n\tglobal_load_lds_dwordx4 %1, off\n\ts_mov_b32 m0, %0" : "=&s"(keep) : "v"(gsrc), "s"(lds_dst) : "memory");
}
struct UnitP { int tok0, dil, s, rho; };
__device__ __forceinline__ UnitP unit_params(int k, int S2) {
    UnitP u; const int br = k >> 4, lb = k & 15;
    if (br == 0) { u.s = S2 * 16 + lb; u.rho = 0; u.dil = 1; u.tok0 = (u.s - 1) * 128; }
    else if (br == 1) { u.s = S2 * 4 + (lb >> 2); u.rho = lb & 3; u.dil = 4; u.tok0 = (u.s - 1) * 512 + u.rho; }
    else { u.s = S2; u.rho = lb; u.dil = 16; u.tok0 = (S2 - 1) * 2048 + lb; }
    return u;
}
__device__ __forceinline__ void attn_dma(unsigned ldsb, const bf16* Kg, const bf16* Vg, int rowbase, int h, const UnitP& u, int wave, int lane) {
    const int slot = lane & 7, lr = lane >> 3;
    const int lc = (((slot >> 1) ^ ((lr >> 1) & 3)) << 1) | (slot & 1);
#pragma unroll
    for (int i = 0; i < 4; ++i) {
        const int p = wave + 8 * i, row = 8 * p + lr;
        int tok = u.tok0 + row * u.dil; tok = tok < 0 ? 0 : tok;
        const size_t off = ((((size_t)(rowbase >> 13) * 8 + h) * 16 + (tok & 15)) * 512 + (tok >> 4)) * 64 + lc * 8;
        const unsigned dst = (unsigned)__builtin_amdgcn_readfirstlane((int)(ldsb + p * 1024));
        glds16(Kg + off, dst); glds16(Vg + off, dst + ATT_V);
    }
}
template <int BR>
__device__ __forceinline__ void attn_compute(const LAS unsigned char* lds, bf16x8 q0, bf16x8 q1, bf16* PO, float* PL, int rowbase, int h, int s, int rho, int wave, int lane,
                                             u32x2_t (&ow)[4], float& olse, bf16*& optr, float*& olptr) {
    constexpr int dil = BR == 0 ? 1 : BR == 1 ? 4 : 16, span = 128 * dil;
    const int ii = lane & 15, g = lane >> 4, w = wave;
    const int tq = s * span + rho + (16 * w + ii) * dil;
    const size_t qrow = (size_t)(rowbase + tq);
    const int xk = (ii >> 1) & 3;
    const LAS unsigned char* kbase = lds + ((16 * w + ii) * 128 + (g & 1) * 16);
    const LAS unsigned char* kb0 = kbase + ((((g >> 1)) ^ xk) << 5); const LAS unsigned char* kb1 = kbase + ((((g >> 1) + 2) ^ xk) << 5);
    f32x4 sc[9];
    {
        bf16x8 kf0[9], kf1[9];
#pragma unroll
        for (int kt = 0; kt < 9; ++kt) { kf0[kt] = *(const LAS bf16x8*)(kb0 + kt * 2048); kf1[kt] = *(const LAS bf16x8*)(kb1 + kt * 2048); }
        __builtin_amdgcn_sched_barrier(0);
#pragma unroll
        for (int kt = 0; kt < 9; ++kt) sc[kt] = __builtin_amdgcn_mfma_f32_16x16x32_bf16(kf0[kt], q0, (f32x4){0.f, 0.f, 0.f, 0.f}, 0, 0, 0);
#pragma unroll
        for (int kt = 0; kt < 9; ++kt) sc[kt] = __builtin_amdgcn_mfma_f32_16x16x32_bf16(kf1[kt], q1, sc[kt], 0, 0, 0);
    }
    const int qv = ii >> 2, pp = ii & 3, xv = (2 * g + (qv >> 1)) & 3;
    const LAS unsigned char* vbase = lds + ATT_V + ((16 * w + 4 * g + qv) * 128 + 8 * pp);
    v4i16_t vlo[5][4], vhi[5][4];
#pragma unroll
    for (int p = 0; p < 5; ++p)
#pragma unroll
        for (int db = 0; db < 4; ++db) { const LAS unsigned char* vb = vbase + ((db ^ xv) << 5) + p * 4096; vlo[p][db] = vtr(vb); vhi[p][db] = vtr(vb + (p < 4 ? 2048 : 0)); }
    __builtin_amdgcn_sched_barrier(0);
    const float NEG = -INFINITY;
#pragma unroll
    for (int r = 0; r < 4; ++r) { if (4 * g + r < ii) sc[0][r] = NEG; if (4 * g + r > ii) sc[8][r] = NEG; }
    if (s == 0) {
#pragma unroll
        for (int kt = 0; kt < 8; ++kt)
#pragma unroll
            for (int r = 0; r < 4; ++r) if (16 * w + 16 * kt + 4 * g + r < 128) sc[kt][r] = NEG;
    }
    float mx = NEG;
#pragma unroll
    for (int kt = 0; kt < 9; ++kt) mx = fmaxf(mx, fmaxf(fmaxf(sc[kt][0], sc[kt][1]), fmaxf(sc[kt][2], sc[kt][3])));
    mx = rows_max(mx);
    float ls = 0.f;
#pragma unroll
    for (int kt = 0; kt < 9; ++kt)
#pragma unroll
        for (int r = 0; r < 4; ++r) { const float p = __builtin_amdgcn_exp2f(sc[kt][r] - mx); sc[kt][r] = p; ls += p; }
    ls = rows_sum(ls);
    f32x4 o[4];
#pragma unroll
    for (int db = 0; db < 4; ++db) o[db] = (f32x4){0.f, 0.f, 0.f, 0.f};
#pragma unroll
    for (int p = 0; p < 5; ++p) {
        pg8::u32x4 pw;
        pw.x = pg8::cvt_pk_bf16(sc[2 * p][0], sc[2 * p][1]); pw.y = pg8::cvt_pk_bf16(sc[2 * p][2], sc[2 * p][3]);
        if (p < 4) { pw.z = pg8::cvt_pk_bf16(sc[2 * p + 1][0], sc[2 * p + 1][1]); pw.w = pg8::cvt_pk_bf16(sc[2 * p + 1][2], sc[2 * p + 1][3]); } else { pw.z = 0u; pw.w = 0u; }
        const bf16x8 pb = __builtin_bit_cast(bf16x8, pw);
#pragma unroll
        for (int db = 0; db < 4; ++db) {
            const v4i16_t lo = vlo[p][db], hi = vhi[p][db];
            const bf16x8 va = (bf16x8){lo[0], lo[1], lo[2], lo[3], hi[0], hi[1], hi[2], hi[3]};
            o[db] = __builtin_amdgcn_mfma_f32_16x16x32_bf16(va, pb, o[db], 0, 0, 0);
        }
    }
    const float linv = __builtin_amdgcn_rcpf(ls);
    const float lse = mx + __builtin_amdgcn_logf(ls);
    optr = PO + (size_t)BR * ((size_t)MP * 512) + qrow * 512 + h * 64 + 4 * g;
#pragma unroll
    for (int db = 0; db < 4; ++db) { ow[db].x = pg8::cvt_pk_bf16(o[db][0] * linv, o[db][1] * linv); ow[db].y = pg8::cvt_pk_bf16(o[db][2] * linv, o[db][3] * linv); }
    olse = lse; olptr = PL + (size_t)BR * ((size_t)MP * 8) + qrow * 8 + h;
}
#define ATT_TOP_WAIT(N) asm volatile("s_waitcnt vmcnt(" #N ") lgkmcnt(0)\n\ts_barrier" ::: "memory")
struct AUnit { int b, h, s, rho, dil, tok0; };
__device__ __forceinline__ AUnit aunit(int xcd, int j, int pp, int i) {
    AUnit u; const int bh = xcd + 8 * pp, v = (j + 32 * i) & 63, br = i >> 1;
    u.b = bh >> 3; u.h = bh & 7;
    if (br == 0) { u.dil = 1; u.s = v; u.rho = 0; u.tok0 = (v - 1) * 128; }
    else if (br == 1) { u.dil = 4; u.s = v >> 2; u.rho = v & 3; u.tok0 = (u.s - 1) * 512 + u.rho; }
    else { u.dil = 16; u.s = v >> 4; u.rho = v & 15; u.tok0 = (u.s - 1) * 2048 + u.rho; }
    return u;
}
__device__ __forceinline__ void attn_units(Frame& F, unsigned char* ws) {
    const int xcd = (F.vcu >> 5) & 7, j = F.vcu & 31;
    const bf16* Qg = (const bf16*)(ws + WS_Z); const bf16* Kg = Qg + (size_t)MROWS * 512; const bf16* Vg = Kg + (size_t)MROWS * 512;
    bf16* PO = (bf16*)(ws + WS_PO); float* PL = (float*)(ws + WS_PL);
    const LAS unsigned char* lds = F.lds + RING_OFF;
    const unsigned ldsb = (unsigned)(uintptr_t)(F.lds + RING_OFF);
    const int ii = F.lane & 15, g = F.lane >> 4;
    const LAS unsigned char* qw = F.lds + QBUF_OFF + F.wave * 2048;
    const unsigned qwb = (unsigned)__builtin_amdgcn_readfirstlane((int)(unsigned)(uintptr_t)qw);
    const unsigned wwb = (unsigned)__builtin_amdgcn_readfirstlane((int)(unsigned)(uintptr_t)(F.lds + WARM_OFF + F.wave * 256));
#define ATT_QDMA(U) do { _Pragma("unroll") for (int j_ = 0; j_ < 2; ++j_) { const int tq_ = (U).s * 128 * (U).dil + (U).rho + (16 * F.wave + 8 * j_ + (F.lane >> 3)) * (U).dil; \
        glds16(Qg + (size_t)((U).b * SEQ + tq_) * 512 + (U).h * 64 + ((F.lane ^ (F.lane >> 3)) & 7) * 8, qwb + j_ * 1024); } } while (0)
#define ATT_QREAD() do { q0 = *(const LAS bf16x8*)(qw + ii * 128 + 16 * (g ^ (ii & 7))); q1 = *(const LAS bf16x8*)(qw + ii * 128 + 16 * ((4 + g) ^ (ii & 7))); LDS_WAIT(); } while (0)
#define ATT_WARM(U) do { const int tq_ = (U).s * 128 * (U).dil + (U).rho + (16 * F.wave + ii) * (U).dil; const bf16* wp_ = Qg + (size_t)((U).b * SEQ + tq_) * 512 + (U).h * 64 + g * 16; unsigned keep_; \
        asm volatile("s_mov_b32 %0, m0\n\ts_mov_b32 m0, %2\n\ts_nop 0\n\tglobal_load_lds_dword %1, off\n\ts_mov_b32 m0, %0" : "=&s"(keep_) : "v"(wp_), "s"(wwb) : "memory"); } while (0)
#define ATT_DMA(U, BUF) do { UnitP up_; up_.tok0 = (U).tok0; up_.dil = (U).dil; up_.s = (U).s; up_.rho = (U).rho; attn_dma(ldsb + (BUF) * ATT_BUF, Kg, Vg, (U).b * SEQ, (U).h, up_, F.wave, F.lane); } while (0)
#define ATT_UNIT(NK) aunit(xcd, j, (NK) / 6, (NK) % 6)
    AUnit u = ATT_UNIT(0), un = u;
    bf16x8 q0, q1;
    u32x2_t pw[4]; float plse = 0.f; bf16* pptr = nullptr; float* plptr = nullptr;
#pragma unroll
    for (int db = 0; db < 4; ++db) pw[db] = (u32x2_t){0u, 0u};
#define ATT_FLUSH() do { if (pptr) { _Pragma("unroll") for (int db_ = 0; db_ < 4; ++db_) *(u32x2_t*)(pptr + 16 * db_) = pw[db_]; if (g == 0) *plptr = plse; pptr = nullptr; } } while (0)
    ATT_QDMA(u); ATT_DMA(u, 0); { const AUnit uw_ = ATT_UNIT(1); ATT_WARM(uw_); }
#define ATT_STEP(BR, K) do { \
        ATT_TOP_WAIT(1); \
        ATT_QREAD(); \
        ATT_FLUSH(); \
        { const int nk_ = (K) + 1; if (nk_ < 48) { un = ATT_UNIT(nk_); ATT_DMA(un, nk_ & 1); ATT_QDMA(un); } \
          const int wk_ = nk_ + 1 < 48 ? nk_ + 1 : 47; const AUnit uw_ = ATT_UNIT(wk_); ATT_WARM(uw_); } \
        attn_compute<BR>(lds + ((K) & 1) * ATT_BUF, q0, q1, PO, PL, u.b * SEQ, u.h, u.s, u.rho, F.wave, F.lane, pw, plse, pptr, plptr); \
        u = un; } while (0)
#pragma unroll 1
    for (int pp = 0; pp < 8; ++pp) {
#pragma unroll 1
        for (int e = 0; e < 2; ++e) ATT_STEP(0, 6 * pp + e);
#pragma unroll 1
        for (int e = 2; e < 4; ++e) ATT_STEP(1, 6 * pp + e);
#pragma unroll 1
        for (int e = 4; e < 6; ++e) ATT_STEP(2, 6 * pp + e);
    }
    ATT_FLUSH();
    VM_WAIT(); LDS_WAIT(); __builtin_amdgcn_s_barrier(); asm volatile("" ::: "memory");
#undef ATT_STEP
#undef ATT_FLUSH
#undef ATT_UNIT
#undef ATT_DMA
#undef ATT_WARM
#undef ATT_QREAD
#undef ATT_QDMA
}
__device__ __forceinline__ void attn_merge(Frame& F, unsigned char* ws) {
    const bf16* PO = (const bf16*)(ws + WS_PO); const float* PL = (const float*)(ws + WS_PL); bf16* MIX = (bf16*)(ws + WS_MIX);
    const int NT = F.G * NWAVES * 64, gt = (F.vcu * NWAVES + F.wave) * 64 + F.lane;
#pragma unroll 4
    for (int idx = gt; idx < MP * 64; idx += NT) {
        const size_t qrow = (size_t)(idx >> 6); const int h = (idx >> 3) & 7, dg = (idx & 7) * 8;
        const float l0 = PL[qrow * 8 + h], l1 = PL[(size_t)MP * 8 + qrow * 8 + h], l2 = PL[(size_t)2 * MP * 8 + qrow * 8 + h];
        const v4u a = *(const v4u*)(PO + qrow * 512 + h * 64 + dg), bb = *(const v4u*)(PO + (size_t)MP * 512 + qrow * 512 + h * 64 + dg), c = *(const v4u*)(PO + (size_t)2 * MP * 512 + qrow * 512 + h * 64 + dg);
        const float mm = fmaxf(fmaxf(l0, l1), l2);
        const float w0 = __builtin_amdgcn_exp2f(l0 - mm), w1 = __builtin_amdgcn_exp2f(l1 - mm), w2 = __builtin_amdgcn_exp2f(l2 - mm);
        const float wi = __builtin_amdgcn_rcpf(w0 + w1 + w2), c0 = w0 * wi, c1 = w1 * wi, c2 = w2 * wi;
#define ATT_MRG(F_) pg8::cvt_pk_bf16(c0 * __builtin_bit_cast(float, a.F_ << 16) + c1 * __builtin_bit_cast(float, bb.F_ << 16) + c2 * __builtin_bit_cast(float, c.F_ << 16), \
                                     c0 * __builtin_bit_cast(float, a.F_ & 0xffff0000u) + c1 * __builtin_bit_cast(float, bb.F_ & 0xffff0000u) + c2 * __builtin_bit_cast(float, c.F_ & 0xffff0000u))
        v4u o; o.x = ATT_MRG(x); o.y = ATT_MRG(y); o.z = ATT_MRG(z); o.w = ATT_MRG(w);
#undef ATT_MRG
        *(v4u*)(MIX + qrow * 1024 + h * 64 + dg) = o;
    }
}
__device__ __forceinline__ void attn_sample_item(LAS unsigned char* wl, const In& in, unsigned char* ws, float* outp, int b, int h, int t, int lane) {
    const int i = lane & 15, g = lane >> 4;
    const bf16* Qg = (const bf16*)(ws + WS_Z);
    const size_t srow = (size_t)MP + b * DECT + t;
    const u32x2_t qw = *(const u32x2_t*)(Qg + srow * 512 + h * 64 + 4 * i);
    const float q0 = __builtin_bit_cast(float, qw.x << 16), q1 = __builtin_bit_cast(float, qw.x & 0xffff0000u), q2 = __builtin_bit_cast(float, qw.y << 16), q3 = __builtin_bit_cast(float, qw.y & 0xffff0000u);
    const float* ckb = in.p[2] + (size_t)b * WBUF * 512 + h * 64; const float* cvb = in.p[3] + (size_t)b * WBUF * 512 + h * 64;
    const float* nk = outp + O_KNS + (size_t)b * DECT * 512 + h * 64; const float* nv = outp + O_VNS + (size_t)b * DECT * 512 + h * 64;
    float m = -1e30f, l = 0.f; f32x4 o = (f32x4){0.f, 0.f, 0.f, 0.f};
    {
        const int cnt = t + 3 + (t >= 4 ? 1 : 0);
        float scn[3]; f32x4 vn[3];
#pragma unroll
        for (int it = 0; it < 3; ++it) {
            const int e = 4 * it + g; int tp = (e <= t) ? t - e : (e == t + 3 ? t - 4 : t); tp = tp < 0 ? 0 : tp;
            const unsigned off = (unsigned)(tp * 512 + 4 * i);
            const f32x4 kv = *(const f32x4*)(nk + off); vn[it] = *(const f32x4*)(nv + off);
            const float s = sum16((q0 * kv[0] + q1 * kv[1]) + (q2 * kv[2] + q3 * kv[3]));
            scn[it] = (e < cnt) ? s : -INFINITY;
        }
        m = fmaxf(m, fmaxf(scn[0], fmaxf(scn[1], scn[2])));
#pragma unroll
        for (int it = 0; it < 3; ++it) { const float p = __builtin_amdgcn_exp2f(scn[it] - m); l += p; o = o + vn[it] * p; }
    }
#define S_SRC(PI, BASE) ({ const int pi_ = (PI) > 98 ? 98 : (PI); const int br_ = pi_ >= 66 ? 2 : (pi_ >= 33 ? 1 : 0); const int j_ = 4 * (pi_ - 33 * br_) + g; \
        int idx_ = WBUF + t - (j_ << (2 * br_)); idx_ = idx_ < 0 ? 0 : (idx_ >= WBUF ? WBUF - 1 : idx_); (BASE) + (unsigned)(idx_ * 512 + 4 * i); })
    const unsigned wlb = (unsigned)__builtin_amdgcn_readfirstlane((int)(unsigned)(uintptr_t)wl);
#pragma unroll
    for (int n = 0; n < 8; ++n) { glds16(S_SRC(n, ckb), wlb + n * 2048); glds16(S_SRC(n, cvb), wlb + n * 2048 + 1024); }
#pragma unroll 1
    for (int pi = 0; pi < 99; ++pi) {
        asm volatile("s_waitcnt vmcnt(14)" ::: "memory");
        const int sb = (pi & 7) * 2048;
        const f32x4 kv = *(const LAS f32x4*)(wl + sb + lane * 16), vv = *(const LAS f32x4*)(wl + sb + 1024 + lane * 16);
        LDS_WAIT();
        glds16(S_SRC(pi + 8, ckb), wlb + sb); glds16(S_SRC(pi + 8, cvb), wlb + sb + 1024);
        const int br = pi >= 66 ? 2 : (pi >= 33 ? 1 : 0), j = 4 * (pi - 33 * br) + g;
        float sv = sum16((q0 * kv[0] + q1 * kv[1]) + (q2 * kv[2] + q3 * kv[3]));
        if (j > 128 || (j << (2 * br)) <= t) sv = -INFINITY;
        const float mn = fmaxf(m, sv), f = __builtin_amdgcn_exp2f(m - mn), pv = __builtin_amdgcn_exp2f(sv - mn);
        l = l * f + pv; o = o * f + vv * pv; m = mn;
    }
    asm volatile("s_waitcnt vmcnt(0)" ::: "memory");
#undef S_SRC
    const float mm = rows_max(m);
    const float f = __builtin_amdgcn_exp2f(m - mm);
    l = rows_sum(l * f);
#pragma unroll
    for (int e = 0; e < 4; ++e) o[e] = rows_sum(o[e] * f);
    if (g == 0) {
        const float li = __builtin_amdgcn_rcpf(l);
        u32x2_t wv; wv.x = pg8::cvt_pk_bf16(o[0] * li, o[1] * li); wv.y = pg8::cvt_pk_bf16(o[2] * li, o[3] * li);
        *(u32x2_t*)((bf16*)(ws + WS_MIX) + srow * 1024 + h * 64 + 4 * i) = wv;
    }
}

constexpr int RW_BYTES = 16384, RW_XCB_PITCH = 144, RW_PITCH = 68;
constexpr int RW_XCF = 16 * RW_XCB_PITCH, RW_AL = RW_XCF + 16 * RW_PITCH * 4, RW_BL = RW_AL + 16 * RW_PITCH * 4;
static_assert(RW_BL + 16 * RW_PITCH * 4 <= RW_BYTES && NWAVES * RW_BYTES <= RING_BYTES, "rnn LDS");
template <bool PASS2>
__device__ __forceinline__ void rnn_wave_item(LAS unsigned char* wl, const In& in, unsigned char* ws, int n, size_t row0, int ntok, float hu3, float hu2, float hu1, float h0, float& ra, float& rb, float (&hu)[3], int lane) {
    const bf16* Ub = (const bf16*)(ws + WS_Z) + (size_t)3 * MROWS * 512 + 64 * n + lane; const bf16* Gb = Ub + (size_t)MROWS * 512;
    bf16* MIX = (bf16*)(ws + WS_MIX) + 512 + 64 * n + lane;
    const int ch = 64 * n + lane, i = lane & 15, g = lane >> 4;
    const float cw0 = in.p[12][ch], cw1 = in.p[12][512 + ch], cw2 = in.p[12][1024 + ch], cw3 = in.p[12][1536 + ch], cb = in.p[13][ch];
    float ba[4], bx[4], sp8[4]; bf16x8 wa[4][2], wx[4][2];
    const bf16* WA = (const bf16*)(ws + WS_WGA) + n * 4096; const bf16* WX = (const bf16*)(ws + WS_WGX) + n * 4096;
#pragma unroll
    for (int db = 0; db < 4; ++db) {
        const int c = 64 * n + 16 * db + i;
        ba[db] = in.p[15][c]; bx[db] = in.p[17][c];
        sp8[db] = 8.0f * log1pf(expf(-in.p[18][c]));
#pragma unroll
        for (int ks = 0; ks < 2; ++ks) { wa[db][ks] = *(const bf16x8*)(WA + (16 * db + i) * 64 + 8 * g + 32 * ks); wx[db][ks] = *(const bf16x8*)(WX + (16 * db + i) * 64 + 8 * g + 32 * ks); }
    }
    float u3 = hu3, u2 = hu2, u1 = hu1, h = h0, P = 1.0f;
    LAS float* XCF = (LAS float*)(wl + RW_XCF); LAS float* AL = (LAS float*)(wl + RW_AL); LAS float* BL = (LAS float*)(wl + RW_BL);
    const int nsub = (ntok + 15) >> 4;
    unsigned short uraw[16], graw[16];
#pragma unroll
    for (int tt = 0; tt < 16; ++tt) { uraw[tt] = (tt < ntok) ? Ub[(row0 + tt) * 512] : (unsigned short)0; graw[tt] = (PASS2 && tt < ntok) ? Gb[(row0 + tt) * 512] : (unsigned short)0; }
    for (int sb = 0; sb < nsub; ++sb) {
        const int nv = (ntok - 16 * sb) < 16 ? (ntok - 16 * sb) : 16;
        const size_t r0 = row0 + 16 * sb;
        unsigned short unx[16], gnx[16];
        const bool more = (sb + 1 < nsub);
#pragma unroll
        for (int tt = 0; tt < 16; ++tt) { unx[tt] = more ? Ub[(r0 + 16 + tt) * 512] : (unsigned short)0; gnx[tt] = (PASS2 && more) ? Gb[(r0 + 16 + tt) * 512] : (unsigned short)0; }
#pragma unroll
        for (int tt = 0; tt < 16; ++tt) {
            float xc = 0.f;
            if (tt < nv) { const float u0 = bf2f(uraw[tt]); xc = cb + cw0 * u3 + cw1 * u2 + cw2 * u1 + cw3 * u0; u3 = u2; u2 = u1; u1 = u0; }
            XCF[tt * RW_PITCH + lane] = xc;
            *(LAS unsigned short*)(wl + tt * RW_XCB_PITCH + lane * 2) = (unsigned short)f2bf(xc);
        }
        LDS_WAIT(); asm volatile("" ::: "memory");
        {
            const bf16x8 a0 = *(const LAS bf16x8*)(wl + i * RW_XCB_PITCH + 16 * g), a1 = *(const LAS bf16x8*)(wl + i * RW_XCB_PITCH + 16 * g + 64);
#pragma unroll
            for (int db = 0; db < 4; ++db) {
                f32x4 da = (f32x4){0.f, 0.f, 0.f, 0.f}, dx = (f32x4){0.f, 0.f, 0.f, 0.f};
                da = __builtin_amdgcn_mfma_f32_16x16x32_bf16(a0, wa[db][0], da, 0, 0, 0); da = __builtin_amdgcn_mfma_f32_16x16x32_bf16(a1, wa[db][1], da, 0, 0, 0);
                dx = __builtin_amdgcn_mfma_f32_16x16x32_bf16(a0, wx[db][0], dx, 0, 0, 0); dx = __builtin_amdgcn_mfma_f32_16x16x32_bf16(a1, wx[db][1], dx, 0, 0, 0);
                const int c = 16 * db + i;
#pragma unroll
                for (int r = 0; r < 4; ++r) {
                    const int tok = 4 * g + r;
                    const float xcv = XCF[tok * RW_PITCH + c];
                    const float rg = fsigmoid(da[r] + ba[db]), ig = fsigmoid(dx[r] + bx[db]);
                    const float log_a = -rg * sp8[db];
                    const float a = __builtin_amdgcn_exp2f(1.4426950408889634f * log_a);
                    const float x2 = 2.0f * log_a;
                    const float em = (x2 > -0.0625f) ? -x2 * (1.0f + x2 * (0.5f + x2 * (0.16666667f + x2 * (0.041666668f + x2 * 0.0083333338f)))) : (1.0f - a * a);
                    const float bt = __builtin_amdgcn_sqrtf(em) * ig * xcv;
                    AL[tok * RW_PITCH + c] = a; BL[tok * RW_PITCH + c] = bt;
                }
            }
        }
        LDS_WAIT(); asm volatile("" ::: "memory");
        if (PASS2) {
#pragma unroll
            for (int tt = 0; tt < 16; ++tt) if (tt < nv) {
                h = AL[tt * RW_PITCH + lane] * h + BL[tt * RW_PITCH + lane];
                const float gv = bf2f(graw[tt]);
                const float z2 = 1.5957691216057308f * (gv + 0.044715f * gv * gv * gv);
                MIX[(r0 + tt) * 1024] = (bf16)f2bf(h * gv * fsigmoid(z2));
            }
        } else {
#pragma unroll
            for (int tt = 0; tt < 16; ++tt) if (tt < nv) { const float a = AL[tt * RW_PITCH + lane]; h = a * h + BL[tt * RW_PITCH + lane]; P *= a; }
        }
        LDS_WAIT(); asm volatile("" ::: "memory");
#pragma unroll
        for (int tt = 0; tt < 16; ++tt) { uraw[tt] = unx[tt]; graw[tt] = gnx[tt]; }
    }
    ra = P; rb = h; hu[0] = u3; hu[1] = u2; hu[2] = u1;
}

template <bool BB, bool OF, bool OB>
__device__ __forceinline__ void sgk_resid(Frame& F, const bf16* A, int K, const bf16* Wt, const float* xs  , bf16* XB, float* outf, float* ss, float alpha) {
    const int i = F.lane & 15, g = F.lane >> 4, w = F.wave;
    LAS float* part = (LAS float*)(F.lds + RING_OFF);
    const int Ks = K >> 3, nsteps = Ks >> 5;
    for (int tile = F.vcu; tile < (MS / 64) * (DM / 64); tile += F.G) {
        const int rt = tile >> 4, ct = tile & 15, arow0 = MP + rt * 64, c0 = ct * 64;
        f32x4 acc[4][4];
#pragma unroll
        for (int bq = 0; bq < 4; ++bq)
#pragma unroll
            for (int ar = 0; ar < 4; ++ar) acc[bq][ar] = (f32x4){0.f, 0.f, 0.f, 0.f};
        const bf16* ap = A + (size_t)(arow0 + i) * K + w * Ks + 8 * g;
        const bf16* bp = Wt + (size_t)(c0 + i) * K + w * Ks + 8 * g;
#pragma unroll 1
        for (int s0 = 0; s0 < nsteps; s0 += 4) {
            bf16x8 fa[4][4], fb[4][4];
#pragma unroll
            for (int st = 0; st < 4; ++st) {
                const int step = (s0 + st < nsteps) ? s0 + st : nsteps - 1;
#pragma unroll
                for (int q = 0; q < 4; ++q) { fa[st][q] = *(const bf16x8*)(ap + (size_t)q * 16 * K + 32 * step); fb[st][q] = *(const bf16x8*)(bp + (size_t)q * 16 * K + 32 * step); }
            }
            __builtin_amdgcn_sched_barrier(0);
#pragma unroll
            for (int st = 0; st < 4; ++st) if (s0 + st < nsteps) {
#pragma unroll
                for (int bq = 0; bq < 4; ++bq)
#pragma unroll
                    for (int ar = 0; ar < 4; ++ar) acc[bq][ar] = __builtin_amdgcn_mfma_f32_16x16x32_bf16(fb[st][bq], fa[st][ar], acc[bq][ar], 0, 0, 0);
            }
        }
#pragma unroll
        for (int bq = 0; bq < 4; ++bq)
#pragma unroll
            for (int ar = 0; ar < 4; ++ar) *(LAS f32x4*)(part + ((w * 64 + 16 * ar + i) * 64 + 16 * bq + 4 * g)) = acc[bq][ar];
        __syncthreads();
        {
            const int row = F.tid >> 3, c8 = (F.tid & 7) * 8, grow = arow0 + row, col = c0 + c8;
            f32x4 s0v = (f32x4){0.f, 0.f, 0.f, 0.f}, s1v = s0v;
#pragma unroll
            for (int ww = 0; ww < 8; ++ww) { const LAS f32x4* pp = (const LAS f32x4*)(part + ((ww * 64 + row) * 64 + c8)); s0v = s0v + pp[0]; s1v = s1v + pp[1]; }
            const size_t off = (size_t)grow * DM + col;
            f32x4 b0, b1;
            if (BB) { const v4u wv = *(const v4u*)(XB + off);
                b0 = (f32x4){__builtin_bit_cast(float, wv.x << 16), __builtin_bit_cast(float, wv.x & 0xffff0000u), __builtin_bit_cast(float, wv.y << 16), __builtin_bit_cast(float, wv.y & 0xffff0000u)};
                b1 = (f32x4){__builtin_bit_cast(float, wv.z << 16), __builtin_bit_cast(float, wv.z & 0xffff0000u), __builtin_bit_cast(float, wv.w << 16), __builtin_bit_cast(float, wv.w & 0xffff0000u)}; }
            else { const f32x4* xp = (const f32x4*)(xs + (size_t)(grow - MP) * DM + col); b0 = xp[0]; b1 = xp[1]; }
            const f32x4 o0 = b0 + s0v * alpha, o1 = b1 + s1v * alpha;
            if (OF) { *(f32x4*)(outf + off) = o0; *(f32x4*)(outf + off + 4) = o1; }
            if (OB) { v4u wv; wv.x = pg8::cvt_pk_bf16(o0[0], o0[1]); wv.y = pg8::cvt_pk_bf16(o0[2], o0[3]); wv.z = pg8::cvt_pk_bf16(o1[0], o1[1]); wv.w = pg8::cvt_pk_bf16(o1[2], o1[3]); *(v4u*)(XB + off) = wv; }
            float q = ((o0[0] * o0[0] + o0[1] * o0[1]) + (o0[2] * o0[2] + o0[3] * o0[3])) + ((o1[0] * o1[0] + o1[1] * o1[1]) + (o1[2] * o1[2] + o1[3] * o1[3]));
            q += dppmov<0xB1>(q); q += dppmov<0x4E>(q); q += dppmov<0x141>(q);
            if ((F.tid & 7) == 0) ss[(size_t)grow * 16 + ct] = q;
        }
        __syncthreads();
    }
}

constexpr int PT_OFF = QBUF_OFF;
static_assert(MISC_OFF + 128 <= LDS_BYTES, "LDS map");

__device__ __forceinline__ void phase_0(Frame& F, const In& in, unsigned char* ws, float* outp) {
    bf16* XB = (bf16*)(ws + WS_XB); bf16* HB = (bf16*)(ws + WS_H); bf16* ZB = (bf16*)(ws + WS_Z); bf16* MIXB = (bf16*)(ws + WS_MIX);
    float* SS0 = (float*)(ws + WS_SS0); float* SS1 = (float*)(ws + WS_SS1); float* SS2 = (float*)(ws + WS_SS2); float* SS3 = (float*)(ws + WS_SS3);
    (void)XB; (void)HB; (void)ZB; (void)MIXB; (void)SS0; (void)SS1; (void)SS2; (void)SS3;
        p0_prologue(F, in, ws);
}
__device__ __forceinline__ void phase_1(Frame& F, const In& in, unsigned char* ws, float* outp) {
    bf16* XB = (bf16*)(ws + WS_XB); bf16* HB = (bf16*)(ws + WS_H); bf16* ZB = (bf16*)(ws + WS_Z); bf16* MIXB = (bf16*)(ws + WS_MIX);
    float* SS0 = (float*)(ws + WS_SS0); float* SS1 = (float*)(ws + WS_SS1); float* SS2 = (float*)(ws + WS_SS2); float* SS3 = (float*)(ws + WS_SS3);
    (void)XB; (void)HB; (void)ZB; (void)MIXB; (void)SS0; (void)SS1; (void)SS2; (void)SS3;
        pg8::Gemm g{XB, (const bf16*)(ws + WS_W1GU), MROWS, NGU, DM}; pg8::StaticOrder S; S.init(MROWS, NGU, F.G, (int)blockIdx.x);
        pg8::EpiSwiGLU<false> E{HB, nullptr, DFF, nullptr};
        pg8::gemm_phase<pg8::EpiSwiGLU<false>, pg8::StaticOrder, true, true>(F.lds + RING_OFF, g, S, E);
}
__device__ __forceinline__ void phase_2(Frame& F, const In& in, unsigned char* ws, float* outp) {
    bf16* XB = (bf16*)(ws + WS_XB); bf16* HB = (bf16*)(ws + WS_H); bf16* ZB = (bf16*)(ws + WS_Z); bf16* MIXB = (bf16*)(ws + WS_MIX);
    float* SS0 = (float*)(ws + WS_SS0); float* SS1 = (float*)(ws + WS_SS1); float* SS2 = (float*)(ws + WS_SS2); float* SS3 = (float*)(ws + WS_SS3);
    (void)XB; (void)HB; (void)ZB; (void)MIXB; (void)SS0; (void)SS1; (void)SS2; (void)SS3;
        pg8::Gemm g{HB, (const bf16*)(ws + WS_W1D), MP, DM, DFF}; pg8::StaticOrder S; S.init(MP, DM, F.G, (int)blockIdx.x);
        pg8::EpiResid<false, false, true, false> E{in.p[0], nullptr, nullptr, XB, SS1, nullptr, 0.5f};
        pg8::gemm_phase<pg8::EpiResid<false, false, true, false>, pg8::StaticOrder, true, true>(F.lds + RING_OFF, g, S, E);
        sgk_resid<false, false, true>(F, HB, DFF, (const bf16*)(ws + WS_W1D), in.p[1], XB, nullptr, SS1, 0.5f);
}
__device__ __forceinline__ void phase_3(Frame& F, const In& in, unsigned char* ws, float* outp) {
    bf16* XB = (bf16*)(ws + WS_XB); bf16* HB = (bf16*)(ws + WS_H); bf16* ZB = (bf16*)(ws + WS_Z); bf16* MIXB = (bf16*)(ws + WS_MIX);
    float* SS0 = (float*)(ws + WS_SS0); float* SS1 = (float*)(ws + WS_SS1); float* SS2 = (float*)(ws + WS_SS2); float* SS3 = (float*)(ws + WS_SS3);
    (void)XB; (void)HB; (void)ZB; (void)MIXB; (void)SS0; (void)SS1; (void)SS2; (void)SS3;
        pg8::Gemm g{XB, (const bf16*)(ws + WS_WIN), MROWS, NIN, DM}; pg8::StaticOrder S; S.init(MROWS, NIN, F.G, (int)blockIdx.x);
        pg8::EpiZ E{ZB, SS1, outp, (LAS float*)(F.lds + PT_OFF)};
        pg8::gemm_phase<pg8::EpiZ, pg8::StaticOrder, true, true>(F.lds + RING_OFF, g, S, E);
}
__device__ __forceinline__ void phase_4(Frame& F, const In& in, unsigned char* ws, float* outp) {
    attn_units(F, ws);
#if defined(DUP_SUB) && DUP_SUB == 2
    attn_units(F, ws);
#endif
    LAS unsigned char* wl = F.lds + RING_OFF + F.wave * RW_BYTES;
    const int ch = 64 * F.wave + F.lane;
    const bf16* Ub = (const bf16*)(ws + WS_Z) + (size_t)3 * MROWS * 512;
    for (int ru = F.vcu; ru < BATCH * NCHUNK; ru += F.G) {
        const int c = ru % NCHUNK, row0 = (ru / NCHUNK) * SEQ + c * 256;
        float h3 = 0.f, h2 = 0.f, h1 = 0.f;
        if (c > 0) { h3 = bf2f(Ub[(size_t)(row0 - 3) * 512 + ch]); h2 = bf2f(Ub[(size_t)(row0 - 2) * 512 + ch]); h1 = bf2f(Ub[(size_t)(row0 - 1) * 512 + ch]); }
        float ra, rb, hu[3];
        rnn_wave_item<false>(wl, in, ws, F.wave, (size_t)row0, 256, h3, h2, h1, 0.f, ra, rb, hu, F.lane);
        ((float*)(ws + WS_RSA))[(size_t)ru * 512 + ch] = ra; ((float*)(ws + WS_RSB))[(size_t)ru * 512 + ch] = rb;
    }
}
__device__ __forceinline__ void phase_5(Frame& F, const In& in, unsigned char* ws, float* outp) {
    attn_merge(F, ws);
#if defined(DUP_SUB) && DUP_SUB == 3
    attn_merge(F, ws);
#endif
    LAS unsigned char* wl = F.lds + RING_OFF + F.wave * RW_BYTES;
    const int ch = 64 * F.wave + F.lane;
    const bf16* Ub = (const bf16*)(ws + WS_Z) + (size_t)3 * MROWS * 512;
#if defined(DUP_SUB) && (DUP_SUB == 4 || DUP_SUB == 5)
#define P5_NH 3
#define P5_SEL(x) ((DUP_SUB == 4) ? ((x) < 2 ? 0 : 1) : ((x) < 1 ? 0 : 1))
#else
#define P5_NH 2
#define P5_SEL(x) (x)
#endif
#pragma unroll 1
    for (int half_ = 0; half_ < P5_NH; ++half_) {
        const int half = P5_SEL(half_);
        if (half == 0) {
            for (int ru = F.vcu; ru < BATCH * NCHUNK + DECB; ru += F.G) {
                float ra, rb, hu[3];
                if (ru < BATCH * NCHUNK) {
                    const int b = ru / NCHUNK, c = ru % NCHUNK, row0 = b * SEQ + c * 256;
                    float h3 = 0.f, h2 = 0.f, h1 = 0.f, h0 = 0.f;
                    if (c > 0) { h3 = bf2f(Ub[(size_t)(row0 - 3) * 512 + ch]); h2 = bf2f(Ub[(size_t)(row0 - 2) * 512 + ch]); h1 = bf2f(Ub[(size_t)(row0 - 1) * 512 + ch]); }
                    const float* RA = (const float*)(ws + WS_RSA) + (size_t)b * NCHUNK * 512 + ch; const float* RB = (const float*)(ws + WS_RSB) + (size_t)b * NCHUNK * 512 + ch;
                    {
                        float fa[NCHUNK - 1], fb[NCHUNK - 1];
#pragma unroll
                        for (int cc = 0; cc < NCHUNK - 1; ++cc) { const int ci = cc < c ? cc : 0; fa[cc] = RA[ci * 512]; fb[cc] = RB[ci * 512]; }
#pragma unroll
                        for (int cc = 0; cc < NCHUNK - 1; ++cc) h0 = cc < c ? fa[cc] * h0 + fb[cc] : h0;
                    }
                    rnn_wave_item<true>(wl, in, ws, F.wave, (size_t)row0, 256, h3, h2, h1, h0, ra, rb, hu, F.lane);
                    if (c == NCHUNK - 1) {
                        outp[O_LHP + b * 512 + ch] = rb;
                        outp[O_LCP + (b * 3 + 0) * 512 + ch] = hu[0]; outp[O_LCP + (b * 3 + 1) * 512 + ch] = hu[1]; outp[O_LCP + (b * 3 + 2) * 512 + ch] = hu[2];
                    }
                } else {
                    const int b = ru - BATCH * NCHUNK, row0 = MP + b * DECT;
                    const float* cs = in.p[5] + (size_t)b * 3 * 512 + ch;
                    rnn_wave_item<true>(wl, in, ws, F.wave, (size_t)row0, DECT, cs[0], cs[512], cs[1024], in.p[4][b * 512 + ch], ra, rb, hu, F.lane);
                    outp[O_LHS + b * 512 + ch] = rb;
                    outp[O_LCS + (b * 3 + 0) * 512 + ch] = hu[0]; outp[O_LCS + (b * 3 + 1) * 512 + ch] = hu[1]; outp[O_LCS + (b * 3 + 2) * 512 + ch] = hu[2];
                }
            }
        } else {
            for (int pr = F.vcu; pr < DECB * NHEAD; pr += F.G) attn_sample_item(wl, in, ws, outp, pr >> 3, F.wave, pr & 7, F.lane);
        }
    }
}
__device__ __forceinline__ void phase_6(Frame& F, const In& in, unsigned char* ws, float* outp) {
    bf16* XB = (bf16*)(ws + WS_XB); bf16* HB = (bf16*)(ws + WS_H); bf16* ZB = (bf16*)(ws + WS_Z); bf16* MIXB = (bf16*)(ws + WS_MIX);
    float* SS0 = (float*)(ws + WS_SS0); float* SS1 = (float*)(ws + WS_SS1); float* SS2 = (float*)(ws + WS_SS2); float* SS3 = (float*)(ws + WS_SS3);
    (void)XB; (void)HB; (void)ZB; (void)MIXB; (void)SS0; (void)SS1; (void)SS2; (void)SS3;
        pg8::Gemm g{MIXB, (const bf16*)(ws + WS_WOUT), MP, DM, DM}; pg8::StaticOrder S; S.init(MP, DM, F.G, (int)blockIdx.x);
        pg8::EpiResid<true, false, true, false> E{nullptr, nullptr, nullptr, XB, SS2, nullptr, 1.0f};
        pg8::gemm_phase<pg8::EpiResid<true, false, true, false>, pg8::StaticOrder, true, true>(F.lds + RING_OFF, g, S, E);
        sgk_resid<true, false, true>(F, MIXB, DM, (const bf16*)(ws + WS_WOUT), nullptr, XB, nullptr, SS2, 1.0f);
}
__device__ __forceinline__ void phase_7(Frame& F, const In& in, unsigned char* ws, float* outp) {
    bf16* XB = (bf16*)(ws + WS_XB); bf16* HB = (bf16*)(ws + WS_H); bf16* ZB = (bf16*)(ws + WS_Z); bf16* MIXB = (bf16*)(ws + WS_MIX);
    float* SS0 = (float*)(ws + WS_SS0); float* SS1 = (float*)(ws + WS_SS1); float* SS2 = (float*)(ws + WS_SS2); float* SS3 = (float*)(ws + WS_SS3);
    (void)XB; (void)HB; (void)ZB; (void)MIXB; (void)SS0; (void)SS1; (void)SS2; (void)SS3;
        pg8::Gemm g{XB, (const bf16*)(ws + WS_W2GU), MROWS, NGU, DM}; pg8::StaticOrder S; S.init(MROWS, NGU, F.G, (int)blockIdx.x);
        pg8::EpiSwiGLU<true> E{HB, SS2, DFF, (LAS float*)(F.lds + PT_OFF)};
        pg8::gemm_phase<pg8::EpiSwiGLU<true>, pg8::StaticOrder, true, true>(F.lds + RING_OFF, g, S, E);
}
__device__ __forceinline__ void phase_8(Frame& F, const In& in, unsigned char* ws, float* outp) {
    bf16* XB = (bf16*)(ws + WS_XB); bf16* HB = (bf16*)(ws + WS_H); bf16* ZB = (bf16*)(ws + WS_Z); bf16* MIXB = (bf16*)(ws + WS_MIX);
    float* SS0 = (float*)(ws + WS_SS0); float* SS1 = (float*)(ws + WS_SS1); float* SS2 = (float*)(ws + WS_SS2); float* SS3 = (float*)(ws + WS_SS3);
    (void)XB; (void)HB; (void)ZB; (void)MIXB; (void)SS0; (void)SS1; (void)SS2; (void)SS3;
        pg8::Gemm g{HB, (const bf16*)(ws + WS_W2D), MP, DM, DFF}; pg8::StaticOrder S; S.init(MP, DM, F.G, (int)blockIdx.x);
        pg8::EpiResid<true, true, false, false> E{nullptr, nullptr, outp + O_Y, XB, SS3, nullptr, 0.5f};
        pg8::gemm_phase<pg8::EpiResid<true, true, false, false>, pg8::StaticOrder, true, true>(F.lds + RING_OFF, g, S, E);
        sgk_resid<true, true, false>(F, HB, DFF, (const bf16*)(ws + WS_W2D), nullptr, XB, outp + O_Y, SS3, 0.5f);
}
__device__ __forceinline__ void phase_9(Frame& F, const In& in, unsigned char* ws, float* outp) {
    bf16* XB = (bf16*)(ws + WS_XB); bf16* HB = (bf16*)(ws + WS_H); bf16* ZB = (bf16*)(ws + WS_Z); bf16* MIXB = (bf16*)(ws + WS_MIX);
    float* SS0 = (float*)(ws + WS_SS0); float* SS1 = (float*)(ws + WS_SS1); float* SS2 = (float*)(ws + WS_SS2); float* SS3 = (float*)(ws + WS_SS3);
    (void)XB; (void)HB; (void)ZB; (void)MIXB; (void)SS0; (void)SS1; (void)SS2; (void)SS3;
        const int gw = F.vcu * NWAVES + F.wave, NGW = F.G * NWAVES;
        const GAS f32x4* lnf = (const GAS f32x4*)in.p[24] + F.lane;
        f32x4 gn[4];
#pragma unroll
        for (int j = 0; j < 4; ++j) gn[j] = lnf[64 * j];
        for (int m0 = gw; m0 < MROWS; m0 += 4 * NGW) {
            f32x4 v[4][4]; float rs[4];
#pragma unroll
            for (int r = 0; r < 4; ++r) {
                const int m = (m0 + r * NGW < MROWS) ? m0 + r * NGW : m0;
                rs[r] = pg8::row_rs16(SS3, m);
                const GAS f32x4* yr = (const GAS f32x4*)(outp + O_Y + (size_t)m * DM) + F.lane;
#pragma unroll
                for (int j = 0; j < 4; ++j) v[r][j] = yr[64 * j];
            }
#pragma unroll
            for (int r = 0; r < 4; ++r) {
                const int m = m0 + r * NGW;
                if (m < MROWS) {
                    GAS f32x4* yr = (GAS f32x4*)(outp + O_Y + (size_t)m * DM) + F.lane;
#pragma unroll
                    for (int j = 0; j < 4; ++j) yr[64 * j] = v[r][j] * rs[r] * gn[j];
                }
            }
        }
}
struct Args { In in; float* out; unsigned char* ws; int ph_lo, ph_hi; };
constexpr int N_PHASES = 10;
#ifndef DUP_PHASE
#define DUP_PHASE (-1)
#endif
__global__ void __launch_bounds__(NWAVES * 64, 2) mega_fwd(Args args) {
    extern __shared__ __attribute__((aligned(16))) unsigned char lds[];
    Frame F;
    F.lds = (LAS unsigned char*)lds;
    F.MISC = (volatile LAS unsigned*)(F.lds + MISC_OFF);
    F.tid = threadIdx.x; F.lane = F.tid & 63; F.wave = __builtin_amdgcn_readfirstlane(F.tid >> 6);
    F.G = gridDim.x; { const int bx = blockIdx.x; F.vcu = (F.G % 8 == 0) ? (bx % 8) * (F.G / 8) + bx / 8 : bx; }
    unsigned char* ws = args.ws; float* outp = args.out; const In& in = args.in;
    F.ctl = (gu32*)(ws + WS_CTL);
    for (int u = F.tid; u < (LDS_BYTES - LDSCTL_OFF) / 4; u += NWAVES * 64) ((LAS unsigned*)(F.lds + LDSCTL_OFF))[u] = 0u;
    __syncthreads();
    const int lo = args.ph_lo, hi = args.ph_hi;
    const bool use_bar = (hi - lo) > 1;
    XcdBarrier bar; bar.bar = (unsigned*)(F.ctl + CW_BAR); bar.x = 0; bar.st = nullptr;
    if (use_bar) bar = xcd_barrier_post((unsigned*)(F.ctl + CW_BAR), F.MISC + 8);
#define IN(k) (lo <= (k) && (k) < hi)
#define SEAM(k) do { if (IN(k) && IN((k) + 1)) xcd_barrier(bar); } while (0)
#define RUN(k) do { if (IN(k)) { phase_##k(F, in, ws, outp); if (DUP_PHASE == (k)) { xcd_barrier(bar); phase_##k(F, in, ws, outp); } } } while (0)
    RUN(0); SEAM(0);
    RUN(1); SEAM(1);
    RUN(2); SEAM(2);
    RUN(3); SEAM(3);
    RUN(4); SEAM(4);
    RUN(5); SEAM(5);
    RUN(6); SEAM(6);
    RUN(7); SEAM(7);
    RUN(8); SEAM(8);
    RUN(9);
#undef IN
#undef SEAM
#undef RUN
}

#ifndef MK_N_LAUNCHES
#define MK_N_LAUNCHES 1
#endif
extern "C" void kernel_launch(void* const* d_in, const int* in_sizes, int n_in, void* d_out, int out_size, void* d_ws, size_t ws_size, hipStream_t stream) {
    static int grid = 0;
    if (grid == 0) {
        if (n_in != 25 || in_sizes[0] != MP * DM || (size_t)out_size != O_END || ws_size < WS_END) { fprintf(stderr, "kernel_launch: unexpected shapes: n_in %d in0 %d out %d ws %zu\n", n_in, n_in > 0 ? in_sizes[0] : -1, out_size, ws_size); grid = -1; return; }
        int dev = 0, cus = 0, per_cu = 0;
        if (hipGetDevice(&dev) != hipSuccess || hipDeviceGetAttribute(&cus, hipDeviceAttributeMultiprocessorCount, dev) != hipSuccess) { grid = -1; return; }
        if (hipFuncSetAttribute((const void*)mega_fwd, hipFuncAttributeMaxDynamicSharedMemorySize, LDS_BYTES) != hipSuccess) { fprintf(stderr, "kernel_launch: hipFuncSetAttribute failed\n"); grid = -1; return; }
        if (hipOccupancyMaxActiveBlocksPerMultiprocessor(&per_cu, (const void*)mega_fwd, NWAVES * 64, LDS_BYTES) != hipSuccess || per_cu < 1) { fprintf(stderr, "kernel_launch: occupancy query says %d\n", per_cu); }
        (void)hipGetLastError();
        grid = cus;
    }
    if (grid < 0) return;
    if (hipMemsetAsync((char*)d_ws + WS_CTL, 0, CTL_ZERO_BYTES, stream) != hipSuccess) return;
    Args a{};
    for (int i = 0; i < 25; ++i) a.in.p[i] = (const float*)d_in[i];
    a.out = (float*)d_out; a.ws = (unsigned char*)d_ws;
#if MK_N_LAUNCHES == 1
    a.ph_lo = 0; a.ph_hi = N_PHASES;
    hipLaunchKernelGGL(mega_fwd, dim3(grid), dim3(NWAVES * 64), LDS_BYTES, stream, a);
#else
    for (int k = 0; k < N_PHASES; ++k) { a.ph_lo = k; a.ph_hi = k + 1; hipLaunchKernelGGL(mega_fwd, dim3(grid), dim3(NWAVES * 64), LDS_BYTES, stream, a); }
#endif
}
```

```cpp
#include <hip/hip_runtime.h>
#include <cstdio>
#include <cstdint>
namespace pg8 {
#define PG8_LAS __attribute__((address_space(3)))
typedef unsigned short bf16_t;
typedef short bf16x8 __attribute__((ext_vector_type(8)));
typedef float f32x4 __attribute__((ext_vector_type(4)));
typedef unsigned u32x4 __attribute__((ext_vector_type(4)));
constexpr int BM = 256, BK = 64, HALF = 128, HTB = HALF * BK * 2  , STAGE_BYTES = 8 * HTB, NXCD = 8, WGM = 8;

__host__ __device__ __forceinline__ int lds_byte(int r, int c) { const int st = (r >> 4) * 2 + (c >> 5), rr = r & 15, cc = c & 31, ob = rr * 64 + cc * 2; return st * 1024 + (ob ^ (((ob >> 9) & 1) << 5)); }
__host__ __device__ __forceinline__ void stage_rc(int b, int& R, int& C) { const int st = b / 1024, sb = b % 1024, swz = sb ^ (((sb >> 9) & 1) << 5); R = (st >> 1) * 16 + swz / 64; C = (st & 1) * 32 + (swz % 64) / 2; }
__host__ __device__ __forceinline__ int perm32(int rho) { const int n = rho >> 4, i = rho & 15; return 8 * (i >> 2) + 4 * n + (i & 3); }

struct Unit { int pm, pn; };
struct Gemm { const bf16_t* A; const bf16_t* Bt; int M, N, K; };

struct StaticOrder {
    int nM, nN, nwg, G, c;
    __host__ __device__ void init(int M, int N, int G_, int c_) { nM = M / BM; nN = N / BM; nwg = nM * nN; G = G_; c = c_; }
    __host__ __device__ bool next(int i, Unit& u) const {
        const long L = (long)i * G + c; if (L >= nwg) return false;
        int wgid = (int)L; { const int q = nwg / NXCD, r = nwg % NXCD, xcd = wgid % NXCD, off = wgid / NXCD; wgid = (xcd < r ? xcd * (q + 1) : r * (q + 1) + (xcd - r) * q) + off; }
        const int nig = WGM * nN, gid = wgid / nig, fm = gid * WGM, gsz = (nM - fm) < WGM ? (nM - fm) : WGM;
        u.pm = fm + ((wgid % nig) % gsz); u.pn = (wgid % nig) / gsz; return true;
    }
    __device__ __forceinline__ void a_ready(const Unit&) const {}
    __device__ __forceinline__ void done(const Unit&) const {}
};
__device__ __forceinline__ unsigned cvt_pk_bf16(float lo, float hi) { unsigned r; asm volatile("v_cvt_pk_bf16_f32 %0, %1, %2" : "=v"(r) : "v"(lo), "v"(hi)); return r; }
typedef float f32x2 __attribute__((ext_vector_type(2)));
constexpr int E_DM = 1024, E_MP = 65536, E_MROWS = 66560;
constexpr size_t E_O_KWP = 68157440, E_O_VWP = 76546048, E_O_KNS = 84951040, E_O_VNS = 85475328;
constexpr float E_QSCALE = 0.125f * 1.4426950408889634f;
typedef unsigned u32x2 __attribute__((ext_vector_type(2)));
__device__ __forceinline__ float row_rs16(const float* ss, int row) {
    const f32x4* p = (const f32x4*)(ss + (size_t)row * 16);
    const f32x4 a = p[0], b = p[1], c = p[2], d = p[3];
    const float s = (((a[0] + a[1]) + (a[2] + a[3])) + ((b[0] + b[1]) + (b[2] + b[3]))) + (((c[0] + c[1]) + (c[2] + c[3])) + ((d[0] + d[1]) + (d[2] + d[3])));
    return __builtin_amdgcn_rsqf(s * (1.0f / 1024.0f) + 1e-6f);
}
__device__ __forceinline__ void rows_to_lds(PG8_LAS float* Rl, const f32x4& pf0, const f32x4& pf1) {
    float s = ((pf0[0] + pf0[1]) + (pf0[2] + pf0[3])) + ((pf1[0] + pf1[1]) + (pf1[2] + pf1[3]));
    s += __builtin_bit_cast(float, __builtin_amdgcn_update_dpp(0, __builtin_bit_cast(int, s), 0xB1, 0xF, 0xF, true));
    if ((threadIdx.x & 1) == 0) Rl[threadIdx.x >> 1] = __builtin_amdgcn_rsqf(s * (1.0f / 1024.0f) + 1e-6f);
    asm volatile("s_waitcnt lgkmcnt(0)\n\ts_barrier" ::: "memory");
}
template <bool RS> struct EpiSwiGLU {
    static constexpr bool PERM = true, AFTER_DRAIN = false, PREFETCH = RS;
    bf16_t* H; const float* ss; int ldh; PG8_LAS float* Rl;
    __device__ __forceinline__ void prefetch(const Unit& u, f32x4& pf0, f32x4& pf1) const {
        const f32x4* p = (const f32x4*)(ss + ((size_t)u.pm * BM + (threadIdx.x >> 1)) * 16 + (threadIdx.x & 1) * 8); pf0 = p[0]; pf1 = p[1];
    }
    __device__ __forceinline__ void operator()(const f32x4 (&acc)[2][2][4][2], const Unit& u, int wr, int wc, int fr, int fq, const f32x4& pf0, const f32x4& pf1) const {
        rows_to_lds(Rl, pf0, pf1);
        run(acc, u, wr, wc, fr, fq);
    }
    __device__ __forceinline__ void operator()(const f32x4 (&acc)[2][2][4][2], const Unit& u, int wr, int wc, int fr, int fq) const { run(acc, u, wr, wc, fr, fq); }
    __device__ __forceinline__ void run(const f32x4 (&acc)[2][2][4][2], const Unit& u, int wr, int wc, int fr, int fq) const {
        typedef float f32x2 __attribute__((ext_vector_type(2)));
        const int row0 = u.pm * BM + wr * 64 + fr, col0 = u.pn * HALF + wc * 32 + 8 * fq;
#pragma unroll
        for (int ai = 0; ai < 2; ++ai) {
            float rs[4];
#pragma unroll
            for (int m = 0; m < 4; ++m) rs[m] = RS ? Rl[ai * HALF + wr * 64 + m * 16 + fr] : 1.0f;
#pragma unroll
            for (int m = 0; m < 4; ++m) {
                const int row = row0 + ai * HALF + m * 16;
                f32x2 hv[4];
#pragma unroll
                for (int n = 0; n < 2; ++n)
#pragma unroll
                    for (int e = 0; e < 2; ++e) {
                        f32x2 t = (f32x2){acc[ai][0][m][n][2 * e], acc[ai][0][m][n][2 * e + 1]};
                        f32x2 p = (f32x2){acc[ai][1][m][n][2 * e], acc[ai][1][m][n][2 * e + 1]};
                        if (RS) { t = t * rs[m]; p = p * rs[m]; }
                        p = p * t;
                        f32x2 d; d.x = __builtin_amdgcn_exp2f(t.x); d.y = __builtin_amdgcn_exp2f(t.y);
                        d = d + 1.0f;
                        f32x2 r; r.x = __builtin_amdgcn_rcpf(d.x); r.y = __builtin_amdgcn_rcpf(d.y);
                        hv[n * 2 + e] = p * r;
                    }
                u32x4 w; w.x = cvt_pk_bf16(hv[0].x, hv[0].y); w.y = cvt_pk_bf16(hv[1].x, hv[1].y); w.z = cvt_pk_bf16(hv[2].x, hv[2].y); w.w = cvt_pk_bf16(hv[3].x, hv[3].y);
                *(u32x4*)(H + (size_t)row * ldh + col0) = w;
            }
        }
    }
};
template <bool BB, bool OF, bool OB, bool PT> struct EpiResid {
    static constexpr bool PERM = true, AFTER_DRAIN = false, PREFETCH = false;
    const float* base; const float* ri; float* outf; bf16_t* xb; float* ss; PG8_LAS float* T; float alpha;
    __device__ __forceinline__ void operator()(const f32x4 (&acc)[2][2][4][2], const Unit& u, int wr, int wc, int fr_, int fq_) const {
        int fr = fr_, fq = fq_; asm volatile("" : "+v"(fr), "+v"(fq));
        const int row0 = u.pm * BM + wr * 64 + fr, col0 = u.pn * BM + wc * 32 + 8 * fq;
#pragma unroll
        for (int ai = 0; ai < 2; ++ai) {
            u32x4 praw[BB ? 4 : 1][2]; f32x4 pre[BB ? 1 : 4][2][2]; float rinv[4];
#pragma unroll
            for (int m = 0; m < 4; ++m) {
                rinv[m] = (BB && ri) ? ri[row0 + ai * HALF + m * 16] : 1.0f;
#pragma unroll
                for (int bj = 0; bj < 2; ++bj) {
                    const size_t off = (size_t)(row0 + ai * HALF + m * 16) * E_DM + col0 + bj * HALF;
                    if (BB) praw[m][bj] = *(const u32x4*)(xb + off);
                    else { pre[m][bj][0] = *(const f32x4*)(base + off); pre[m][bj][1] = *(const f32x4*)(base + off + 4); }
                }
            }
            if (BB) asm volatile("" ::: "memory");
#pragma unroll
            for (int m = 0; m < 4; ++m) {
                const int row = row0 + ai * HALF + m * 16; float q = 0.f;
#pragma unroll
                for (int bj = 0; bj < 2; ++bj) {
                    const size_t off = (size_t)row * E_DM + col0 + bj * HALF;
                    f32x4 b0, b1;
                    if (BB) { const u32x4 w = praw[BB ? m : 0][bj];
                        b0 = (f32x4){__builtin_bit_cast(float, w.x << 16), __builtin_bit_cast(float, w.x & 0xffff0000u), __builtin_bit_cast(float, w.y << 16), __builtin_bit_cast(float, w.y & 0xffff0000u)} * rinv[m];
                        b1 = (f32x4){__builtin_bit_cast(float, w.z << 16), __builtin_bit_cast(float, w.z & 0xffff0000u), __builtin_bit_cast(float, w.w << 16), __builtin_bit_cast(float, w.w & 0xffff0000u)} * rinv[m]; }
                    else { b0 = pre[BB ? 0 : m][bj][0]; b1 = pre[BB ? 0 : m][bj][1]; }
                    const f32x4 o0 = b0 + acc[ai][bj][m][0] * alpha, o1 = b1 + acc[ai][bj][m][1] * alpha;
                    if (OF) { *(f32x4*)(outf + off) = o0; *(f32x4*)(outf + off + 4) = o1; }
                    q += ((o0[0] * o0[0] + o0[1] * o0[1]) + (o0[2] * o0[2] + o0[3] * o0[3])) + ((o1[0] * o1[0] + o1[1] * o1[1]) + (o1[2] * o1[2] + o1[3] * o1[3]));
                    if (OB) { u32x4 w; w.x = cvt_pk_bf16(o0[0], o0[1]); w.y = cvt_pk_bf16(o0[2], o0[3]); w.z = cvt_pk_bf16(o1[0], o1[1]); w.w = cvt_pk_bf16(o1[2], o1[3]); *(u32x4*)(xb + off) = w; }
                }
                q += __shfl_xor(q, 16); q += __shfl_xor(q, 32);
                if (fq == 0) ss[(size_t)row * 16 + u.pn * 4 + wc] = q;
            }
        }
    }
};
struct EpiZ {
    static constexpr bool PERM = true, AFTER_DRAIN = false, PREFETCH = true;
    bf16_t* Z; const float* ss; float* outp; PG8_LAS float* Rl;
    __device__ __forceinline__ void prefetch(const Unit& u, f32x4& pf0, f32x4& pf1) const {
        const f32x4* p = (const f32x4*)(ss + ((size_t)u.pm * BM + (threadIdx.x >> 1)) * 16 + (threadIdx.x & 1) * 8); pf0 = p[0]; pf1 = p[1];
    }
    __device__ __forceinline__ void operator()(const f32x4 (&acc)[2][2][4][2], const Unit& u, int wr, int wc, int fr, int fq, const f32x4& pf0, const f32x4& pf1) const {
        rows_to_lds(Rl, pf0, pf1);
        const int t = u.pn >> 1, colt = (u.pn & 1) * BM;
        bf16_t* zb = Z + (size_t)t * ((size_t)E_MROWS * 512);
        const float sc = (t == 0) ? E_QSCALE : 1.0f;
        const int row0 = u.pm * BM + wr * 64 + fr, col0 = colt + wc * 32 + 8 * fq;
        const bool wout = (t == 1 || t == 2) && (u.pm >= 256 || (u.pm & 31) >= 24);
#pragma unroll
        for (int ai = 0; ai < 2; ++ai) {
            float rs[4];
#pragma unroll
            for (int m = 0; m < 4; ++m) rs[m] = Rl[ai * HALF + wr * 64 + m * 16 + fr] * sc;
#pragma unroll
            for (int m = 0; m < 4; ++m) {
                const int row = row0 + ai * HALF + m * 16;
                size_t oo = 0;
                if (wout) { if (row < E_MP) oo = (t == 1 ? E_O_KWP : E_O_VWP) + ((size_t)((row >> 13) * 2048 + (row & 8191) - 6144)) * 512; else oo = (t == 1 ? E_O_KNS : E_O_VNS) + (size_t)(row - E_MP) * 512; }
#pragma unroll
                for (int bj = 0; bj < 2; ++bj) {
                    const f32x4 v0 = acc[ai][bj][m][0] * rs[m], v1 = acc[ai][bj][m][1] * rs[m];
                    u32x4 w; w.x = cvt_pk_bf16(v0[0], v0[1]); w.y = cvt_pk_bf16(v0[2], v0[3]); w.z = cvt_pk_bf16(v1[0], v1[1]); w.w = cvt_pk_bf16(v1[2], v1[3]);
                    if (t == 1 || t == 2) {
                        if (row < E_MP) { const int cc = col0 + bj * HALF; *(u32x4*)(zb + ((((size_t)(row >> 13) * 8 + (cc >> 6)) * 16 + (row & 15)) * 512 + ((row & 8191) >> 4)) * 64 + (cc & 63)) = w; }
                    } else *(u32x4*)(zb + (size_t)row * 512 + col0 + bj * HALF) = w;
                    if (wout) { float* op = outp + oo + col0 + bj * HALF; *(f32x4*)op = v0; *(f32x4*)(op + 4) = v1; }
                }
            }
        }
    }
};

template <class Epi, class Sched, bool ALIGN_EPI = false, bool SP2 = false>
__device__ __forceinline__ void gemm_phase(PG8_LAS unsigned char* lds, const Gemm g, const Sched& S, const Epi& E) {
    const int tid = threadIdx.x, wid = __builtin_amdgcn_readfirstlane(tid >> 6), lane = tid & 63, wr = wid >> 2, wc = wid & 3, fr = lane & 15, fq = lane >> 4;
    const int K = g.K, nt = K / BK;
    unsigned voffA[2], voffB[2];
#pragma unroll
    for (int i = 0; i < 2; ++i) { int R, C; stage_rc(tid * 16 + i * 8192, R, C); const int Rb = Epi::PERM ? ((R & ~31) + perm32(R & 31)) : R;
        voffA[i] = (unsigned)(R * K + C) * 2u; voffB[i] = (unsigned)(Rb * K + C) * 2u; }
    const size_t kstep = (size_t)(BK * 2);
    const size_t hstep = (size_t)HALF * K * 2;
    const size_t tstep = 2 * hstep;
    const unsigned ldsw = (unsigned)wid * 1024u;
    const int aoff = lds_byte(wr * 64 + fr, fq * 8), boff = lds_byte(wc * 32 + fr, fq * 8);
#define PG8_SA(b, h) (((b) * 2 + (h)) * HTB)
#define PG8_SB(b, h) ((4 + (b) * 2 + (h)) * HTB)
#define PG8_STAGE(bufoff, gbase, voff) do { _Pragma("unroll") for (int _i = 0; _i < 2; ++_i) \
        __builtin_amdgcn_global_load_lds((const unsigned*)((const char*)(gbase) + (voff)[_i]), (PG8_LAS unsigned*)(lds + (bufoff) + ldsw + _i * 8192), 16, 0, 0); } while (0)
#define PG8_LDA(dst, b, h) do { _Pragma("unroll") for (int m = 0; m < 4; ++m) _Pragma("unroll") for (int k = 0; k < 2; ++k) dst[m][k] = *(const PG8_LAS bf16x8*)(lds + PG8_SA(b, h) + aoff + m * 2048 + k * 1024); } while (0)
#define PG8_LDB(dst, b, h) do { _Pragma("unroll") for (int n = 0; n < 2; ++n) _Pragma("unroll") for (int k = 0; k < 2; ++k) dst[n][k] = *(const PG8_LAS bf16x8*)(lds + PG8_SB(b, h) + boff + n * 2048 + k * 1024); } while (0)
#define PG8_MMA(ai, bj, At, Bt) do { __builtin_amdgcn_s_setprio(1); _Pragma("unroll") for (int m = 0; m < 4; ++m) _Pragma("unroll") for (int n = 0; n < 2; ++n) _Pragma("unroll") for (int k = 0; k < 2; ++k) \
        acc[ai][bj][m][n] = __builtin_amdgcn_mfma_f32_16x16x32_bf16(Bt[n][k], At[m][k], acc[ai][bj][m][n], 0, 0, 0); __builtin_amdgcn_s_setprio(0); } while (0)
#define PG8_WAIT_V(n) asm volatile("s_waitcnt vmcnt(" #n ")" ::: "memory")
#define PG8_WAIT_L(n) asm volatile("s_waitcnt lgkmcnt(" #n ")" ::: "memory")
#define PG8_BAR __builtin_amdgcn_s_barrier()
#define PG8_SCHED __builtin_amdgcn_sched_barrier(0)
    Unit cur, nxt; int ui = 0;
    if (!S.next(0, cur)) return;
    f32x4 acc[2][2][4][2];
    f32x4 pf0 = (f32x4){0.f, 0.f, 0.f, 0.f}, pf1 = pf0;
#pragma unroll
    for (int a = 0; a < 2; ++a)
#pragma unroll
        for (int b = 0; b < 2; ++b)
#pragma unroll
            for (int m = 0; m < 4; ++m)
#pragma unroll
                for (int n = 0; n < 2; ++n) acc[a][b][m][n] = (f32x4){0.f, 0.f, 0.f, 0.f};
    bf16x8 At[4][2], B0[2][2], B1[2][2];
    const char* cA = (const char*)g.A + (size_t)cur.pm * tstep; const char* cB = (const char*)g.Bt + (size_t)cur.pn * tstep;
    S.a_ready(cur);
    if constexpr (SP2) {
        PG8_STAGE(PG8_SB(0, 0), cB, voffB); PG8_STAGE(PG8_SB(0, 1), cB + hstep, voffB); PG8_STAGE(PG8_SA(0, 0), cA, voffA); PG8_STAGE(PG8_SA(0, 1), cA + hstep, voffA);
        if (wr == 1) PG8_BAR;
        PG8_WAIT_V(2); PG8_BAR;
        PG8_STAGE(PG8_SB(1, 0), cB + kstep, voffB); PG8_STAGE(PG8_SA(1, 0), cA + kstep, voffA); PG8_STAGE(PG8_SB(1, 1), cB + hstep + kstep, voffB);
        PG8_WAIT_V(6); PG8_BAR;
    } else {
        PG8_STAGE(PG8_SB(0, 0), cB, voffB); PG8_STAGE(PG8_SA(0, 0), cA, voffA); PG8_STAGE(PG8_SB(0, 1), cB + hstep, voffB); PG8_STAGE(PG8_SA(0, 1), cA + hstep, voffA);
        if (wr == 1) PG8_BAR;
        PG8_WAIT_V(4); PG8_BAR;
        PG8_STAGE(PG8_SB(1, 0), cB + kstep, voffB); PG8_STAGE(PG8_SA(1, 0), cA + kstep, voffA); PG8_STAGE(PG8_SB(1, 1), cB + hstep + kstep, voffB);
        PG8_WAIT_V(6); PG8_BAR;
    }
    for (;;) {
        const bool has_next = S.next(ui + 1, nxt);
        const char* nA = has_next ? (const char*)g.A + (size_t)nxt.pm * tstep : cA; const char* nB = has_next ? (const char*)g.Bt + (size_t)nxt.pn * tstep : cB;
        for (int t = 0; t < nt; t += 2) {
            const bool last = (t == nt - 2);
            const char* a1 = cA + (size_t)(t + 1) * kstep;
            const char* a2 = last ? nA : cA + (size_t)(t + 2) * kstep; const char* b2 = last ? nB : cB + (size_t)(t + 2) * kstep;
            const char* a3 = a2 + kstep; const char* b3 = b2 + kstep;
            if (last && has_next) S.a_ready(nxt);
            if constexpr (Epi::PREFETCH) { if (last) E.prefetch(cur, pf0, pf1); }
            if constexpr (SP2) {
            PG8_LDB(B0, 0, 0); PG8_LDB(B1, 0, 1); PG8_SCHED; PG8_LDA(At, 0, 0); PG8_STAGE(PG8_SA(1, 1), a1 + hstep, voffA);
            PG8_WAIT_V(8); PG8_WAIT_L(0); PG8_BAR; PG8_MMA(0, 0, At, B0); PG8_MMA(0, 1, At, B1); PG8_BAR; PG8_SCHED;
            PG8_LDA(At, 0, 1); PG8_STAGE(PG8_SB(0, 0), b2, voffB); PG8_STAGE(PG8_SB(0, 1), b2 + hstep, voffB); PG8_STAGE(PG8_SA(0, 0), a2, voffA);
            PG8_WAIT_V(8); PG8_WAIT_L(0); PG8_BAR; PG8_MMA(1, 0, At, B0); PG8_MMA(1, 1, At, B1); PG8_BAR; PG8_SCHED;
            PG8_LDB(B0, 1, 0); PG8_LDB(B1, 1, 1); PG8_SCHED; PG8_LDA(At, 1, 0); PG8_STAGE(PG8_SA(0, 1), a2 + hstep, voffA);
            PG8_WAIT_V(8); PG8_WAIT_L(0); PG8_BAR; PG8_MMA(0, 0, At, B0); PG8_MMA(0, 1, At, B1); PG8_BAR; PG8_SCHED;
            PG8_LDA(At, 1, 1); PG8_STAGE(PG8_SB(1, 0), b3, voffB); PG8_STAGE(PG8_SB(1, 1), b3 + hstep, voffB); PG8_STAGE(PG8_SA(1, 0), a3, voffA);
            PG8_WAIT_V(8); PG8_WAIT_L(0); PG8_BAR; PG8_MMA(1, 0, At, B0); PG8_MMA(1, 1, At, B1); PG8_BAR; PG8_SCHED;
            } else {
            PG8_LDB(B0, 0, 0); PG8_SCHED; PG8_LDA(At, 0, 0); PG8_STAGE(PG8_SA(1, 1), a1 + hstep, voffA);
            PG8_WAIT_L(8); PG8_BAR; PG8_WAIT_L(0); PG8_MMA(0, 0, At, B0); PG8_BAR; PG8_SCHED;
            PG8_LDB(B1, 0, 1); PG8_STAGE(PG8_SB(0, 0), b2, voffB);
            PG8_BAR; PG8_WAIT_L(0); PG8_MMA(0, 1, At, B1); PG8_BAR;
            PG8_LDA(At, 0, 1); PG8_STAGE(PG8_SA(0, 0), a2, voffA);
            PG8_BAR; PG8_WAIT_L(0); PG8_MMA(1, 0, At, B0); PG8_BAR; PG8_SCHED;
            PG8_STAGE(PG8_SB(0, 1), b2 + hstep, voffB);
            PG8_WAIT_V(6); PG8_BAR; PG8_MMA(1, 1, At, B1); PG8_BAR;
            PG8_LDB(B0, 1, 0); PG8_SCHED; PG8_LDA(At, 1, 0); PG8_STAGE(PG8_SA(0, 1), a2 + hstep, voffA);
            PG8_WAIT_L(8); PG8_BAR; PG8_WAIT_L(0); PG8_MMA(0, 0, At, B0); PG8_BAR; PG8_SCHED;
            PG8_LDB(B1, 1, 1); PG8_STAGE(PG8_SB(1, 0), b3, voffB);
            PG8_BAR; PG8_WAIT_L(0); PG8_MMA(0, 1, At, B1); PG8_BAR;
            PG8_LDA(At, 1, 1); PG8_STAGE(PG8_SA(1, 0), a3, voffA);
            PG8_BAR; PG8_WAIT_L(0); PG8_MMA(1, 0, At, B0); PG8_BAR; PG8_SCHED;
            PG8_STAGE(PG8_SB(1, 1), b3 + hstep, voffB);
            PG8_WAIT_V(6); PG8_BAR; PG8_MMA(1, 1, At, B1); PG8_BAR;
            }
        }
        if constexpr (ALIGN_EPI) { if (wr == 0) PG8_BAR; }
        if constexpr (!Epi::AFTER_DRAIN) { if constexpr (Epi::PREFETCH) E(acc, cur, wr, wc, fr, fq, pf0, pf1); else E(acc, cur, wr, wc, fr, fq); S.done(cur); }
        if (!has_next) break;
#pragma unroll
        for (int a = 0; a < 2; ++a)
#pragma unroll
            for (int b = 0; b < 2; ++b)
#pragma unroll
                for (int m = 0; m < 4; ++m)
#pragma unroll
                    for (int n = 0; n < 2; ++n) acc[a][b][m][n] = (f32x4){0.f, 0.f, 0.f, 0.f};
        cur = nxt; cA = nA; cB = nB; ++ui;
        if constexpr (ALIGN_EPI) { if (wr == 1) PG8_BAR; }
    }
    PG8_WAIT_V(0);
    if constexpr (!ALIGN_EPI) { if (wr == 0) PG8_BAR; }
    PG8_BAR;
    if constexpr (Epi::AFTER_DRAIN) { E.fused(acc, cur, wr, wc, fr, fq, lds, wid, lane); S.done(cur); }
#undef PG8_SA
#undef PG8_SB
#undef PG8_STAGE
#undef PG8_LDA
#undef PG8_LDB
#undef PG8_MMA
#undef PG8_WAIT_V
#undef PG8_WAIT_L
#undef PG8_BAR
#undef PG8_SCHED
}
}
#define GAS __attribute__((address_space(1)))
#define LAS __attribute__((address_space(3)))
typedef unsigned short bf16;
typedef unsigned v4u __attribute__((ext_vector_type(4)));
typedef float f32x4 __attribute__((ext_vector_type(4)));
typedef short bf16x8 __attribute__((ext_vector_type(8)));
typedef GAS unsigned gu32;
typedef GAS unsigned long long gu64;
#define RLX_AGENT __ATOMIC_RELAXED, __HIP_MEMORY_SCOPE_AGENT
#define LDS_WAIT() asm volatile("s_waitcnt lgkmcnt(0)" ::: "memory")
#define VM_WAIT() asm volatile("s_waitcnt vmcnt(0)" ::: "memory")
__device__ __forceinline__ unsigned long long rt() { return __builtin_amdgcn_s_memrealtime(); }
__device__ __forceinline__ unsigned f2bf(float f) { unsigned u = __builtin_bit_cast(unsigned, f); return (u + 0x7fffu + ((u >> 16) & 1u)) >> 16; }
__device__ __forceinline__ unsigned pk2(float lo, float hi) { return f2bf(lo) | (f2bf(hi) << 16); }

#define XB_TMO      128
#define XB_XCNT(j)  (256  + 64 * (j))
#define XB_XSUB(j)  (1280 + 64 * (j))
#define XB_XGEN(j)  (2304 + 64 * (j))
#define XB_TOP      3328
#define XB_TOPGEN   3392
#define XCD_BAR_WORDS 3456
#define XB_SPIN_CAP (1u << 18)

__device__ __forceinline__ unsigned xb_ld(unsigned* p)              { return __hip_atomic_load(p, __ATOMIC_RELAXED, __HIP_MEMORY_SCOPE_AGENT); }
__device__ __forceinline__ unsigned xb_add(unsigned* p, unsigned v) { return __hip_atomic_fetch_add(p, v, __ATOMIC_RELAXED, __HIP_MEMORY_SCOPE_AGENT); }
__device__ __forceinline__ unsigned xb_xcc_id() { return (unsigned)__builtin_amdgcn_s_getreg((3 << 11) | 20) & 0xFu; }
#define XB_SPIN(cond, bar) do { unsigned _sp = 0; while (cond) { __builtin_amdgcn_s_sleep(1); \
    if ((++_sp & 255u) == 0u) { if (xb_ld(&(bar)[XB_TMO])) break; if (_sp > XB_SPIN_CAP) { atomicAdd(&(bar)[XB_TMO], 1u); break; } } } } while (0)

struct XcdBarrier {
    unsigned* bar; unsigned x;
    volatile LAS unsigned* st;
};

__device__ __forceinline__ XcdBarrier xcd_barrier_post(unsigned* bar, volatile LAS unsigned* st) {
    XcdBarrier b; b.bar = bar; b.x = xb_xcc_id(); b.st = st;
    if (threadIdx.x == 0) (void)xb_add(&bar[XB_XCNT(b.x)], 1u);
    return b;
}
__device__ __forceinline__ void xcd_barrier_complete(unsigned* bar, unsigned x, unsigned& nloc, unsigned& nx) {
    const unsigned G = gridDim.x * gridDim.y * gridDim.z;
    unsigned sum, cnt, mine, sp = 0u;
    for (;;) {
        sum = 0u; cnt = 0u; mine = 0u;
#pragma unroll
        for (unsigned j = 0; j < 16; ++j) { const unsigned c = xb_ld(&bar[XB_XCNT(j)]); sum += c; cnt += (c > 0u) ? 1u : 0u; mine = (j == x) ? c : mine; }
        if (sum == G) break;
        __builtin_amdgcn_s_sleep(1);
        if ((++sp & 255u) == 0u) { if (xb_ld(&bar[XB_TMO])) break; if (sp > XB_SPIN_CAP) { atomicAdd(&bar[XB_TMO], 1u); break; } }
    }
    nloc = mine > 0u ? mine : 1u; nx = cnt > 0u ? cnt : 1u;
}

__device__ __forceinline__ void xcd_barrier(const XcdBarrier& b) {
    asm volatile("s_waitcnt vmcnt(0)" ::: "memory");
    __syncthreads();
    if (threadIdx.x == 0) {
        unsigned* bar = b.bar;
        __builtin_amdgcn_s_waitcnt(0);
        unsigned nloc = b.st[0], nx = b.st[1];
        if (nloc == 0u) { xcd_barrier_complete(bar, b.x, nloc, nx); b.st[0] = nloc; b.st[1] = nx; }
        const unsigned old = xb_add(&bar[XB_XSUB(b.x)], 1u);
        const unsigned gen = old / nloc;
        if (old + 1u == (gen + 1u) * nloc) {
            __builtin_amdgcn_fence(__ATOMIC_RELEASE, "agent");
            asm volatile("s_waitcnt vmcnt(0)" ::: "memory");
            const unsigned og = xb_add(&bar[XB_TOP], 1u);
            const unsigned tg = og / nx;
            if (og + 1u == (tg + 1u) * nx) xb_add(&bar[XB_TOPGEN], 1u);
            else XB_SPIN(xb_ld(&bar[XB_TOPGEN]) == tg, bar);
            __builtin_amdgcn_fence(__ATOMIC_ACQUIRE, "agent");
            xb_add(&bar[XB_XGEN(b.x)], 1u);
            asm volatile("s_waitcnt vmcnt(0)" ::: "memory");
        } else {
            XB_SPIN(xb_ld(&bar[XB_XGEN(b.x)]) == gen, bar);
            __builtin_amdgcn_fence(__ATOMIC_ACQUIRE, "agent");
            asm volatile("s_waitcnt vmcnt(0)" ::: "memory");
        }
    }
    __syncthreads();
}

constexpr int NWAVES = 8;
constexpr int DM = 1024, DFF = 2816, NHEAD = 8, HD = 64, DATT = 512, DRNN = 512;
constexpr int BATCH = 8, SEQ = 8192, DECB = 128, DECT = 8, WBUF = 2048;
constexpr int MP = BATCH * SEQ, MS = DECB * DECT, MROWS = MP + MS;
constexpr int NGU = 2 * DFF, NIN = 3 * DATT + 2 * DRNN;
constexpr int NCHUNK = SEQ / 256;
static_assert(MROWS % 256 == 0 && MROWS == pg8::E_MROWS && MP == pg8::E_MP && DM == pg8::E_DM, "shapes");
constexpr size_t O_Y = 0, O_KWP = 68157440, O_VWP = 76546048, O_LHP = 84934656, O_LCP = 84938752, O_KNS = 84951040, O_VNS = 85475328, O_LHS = 85999616, O_LCS = 86065152, O_END = 86261760;
static_assert(O_KWP == pg8::E_O_KWP && O_VWP == pg8::E_O_VWP && O_KNS == pg8::E_O_KNS && O_VNS == pg8::E_O_VNS, "offsets");
constexpr size_t MiB = 1u << 20;
constexpr size_t WS_CTL = 0, CTL_ZERO_BYTES = 1 * MiB;
constexpr size_t WS_W1GU = 2 * MiB, WS_W1D = 13 * MiB, WS_WIN = 19 * MiB, WS_WOUT = 24 * MiB, WS_W2GU = 26 * MiB, WS_W2D = 37 * MiB, WS_WGA = 43 * MiB, WS_WGX = 43 * MiB + 65536;
constexpr size_t WS_SS0 = 44 * MiB  , WS_SS1 = 49 * MiB, WS_SS2 = 54 * MiB, WS_SS3 = 59 * MiB;
constexpr size_t WS_RSA = 64 * MiB, WS_RSB = 64 * MiB + 524288;
constexpr size_t WS_RI0 = 65 * MiB;
constexpr size_t WS_PL = 66 * MiB;
constexpr size_t WS_XB = 128 * MiB;
constexpr size_t WS_H = 258 * MiB;
constexpr size_t WS_PO = 258 * MiB;
constexpr size_t WS_Z = 616 * MiB;
constexpr size_t WS_MIX = 941 * MiB;
constexpr size_t WS_END = 1072 * MiB;
constexpr int CW_BAR = 4096;
constexpr int RING_OFF = 0, RING_BYTES = 131072;
constexpr int QBUF_OFF = RING_BYTES, QBUF_BYTES = 16384;
constexpr int WARM_OFF = QBUF_OFF + QBUF_BYTES, WARM_BYTES = 2048;
constexpr int LDSCTL_OFF = WARM_OFF + WARM_BYTES, MISC_OFF = LDSCTL_OFF + 320;
constexpr int LDS_BYTES = 150528;

struct Frame {
    LAS unsigned char* lds;
    volatile LAS unsigned* MISC;
    gu32* ctl;
    int tid, lane, wave;
    int vcu, G;
};

__device__ __forceinline__ float wave_sum(float v) {
#pragma unroll
    for (int o = 1; o < 64; o <<= 1) v += __shfl_xor(v, o);
    return v;
}
__device__ __forceinline__ float bf2f(unsigned short b) { return __builtin_bit_cast(float, (unsigned)b << 16); }
__device__ __forceinline__ float fsigmoid(float x) { return __builtin_amdgcn_rcpf(1.0f + __builtin_amdgcn_exp2f(-1.4426950408889634f * x)); }

template <int CTRL> __device__ __forceinline__ float dppmov(float v) { return __builtin_bit_cast(float, __builtin_amdgcn_update_dpp(0, __builtin_bit_cast(int, v), CTRL, 0xF, 0xF, true)); }
__device__ __forceinline__ float sum16(float v) {
    v += dppmov<0xB1>(v); v += dppmov<0x4E>(v); v += dppmov<0x141>(v); v += dppmov<0x140>(v); return v;
}
__device__ __forceinline__ float rows_max(float v) {
    { auto rr = __builtin_amdgcn_permlane16_swap(__float_as_uint(v), __float_as_uint(v), false, false); v = fmaxf(__uint_as_float(rr[0]), __uint_as_float(rr[1])); }
    { auto rr = __builtin_amdgcn_permlane32_swap(__float_as_uint(v), __float_as_uint(v), false, false); v = fmaxf(__uint_as_float(rr[0]), __uint_as_float(rr[1])); }
    return v;
}
__device__ __forceinline__ float rows_sum(float v) {
    { auto rr = __builtin_amdgcn_permlane16_swap(__float_as_uint(v), __float_as_uint(v), false, false); v = __uint_as_float(rr[0]) + __uint_as_float(rr[1]); }
    { auto rr = __builtin_amdgcn_permlane32_swap(__float_as_uint(v), __float_as_uint(v), false, false); v = __uint_as_float(rr[0]) + __uint_as_float(rr[1]); }
    return v;
}

__device__ __forceinline__ void p0_transpose_item(const float* W, int ldw, const float* ksc, int k0, int n0, bf16* WT, int K, int dst_row0, LAS float* scr, int lane, float kmul = 1.0f) {
    float wv[32], wsc[32];
#pragma unroll
    for (int i = 0; i < 32; ++i) { const int kk = 2 * i + (lane >> 5); wv[i] = W[(size_t)(k0 + kk) * ldw + n0 + (lane & 31)]; wsc[i] = ksc ? ksc[k0 + kk] * kmul : kmul; }
#pragma unroll
    for (int i = 0; i < 32; ++i) { const int kk = 2 * i + (lane >> 5); scr[kk * 33 + (lane & 31)] = wv[i] * wsc[i]; }
    LDS_WAIT(); asm volatile("" ::: "memory");
    const int c = lane & 7;
#pragma unroll
    for (int j = 0; j < 4; ++j) { const int n = (lane >> 3) + 8 * j; const LAS float* s = scr + (8 * c) * 33 + n;
        v4u o; o.x = pk2(s[0 * 33], s[1 * 33]); o.y = pk2(s[2 * 33], s[3 * 33]); o.z = pk2(s[4 * 33], s[5 * 33]); o.w = pk2(s[6 * 33], s[7 * 33]);
        *(GAS v4u*)(WT + (size_t)(dst_row0 + n) * K + k0 + 8 * c) = o; }
    LDS_WAIT(); asm volatile("" ::: "memory");
}
struct In { const float* p[25]; };
__device__ __forceinline__ void p0_prologue(Frame& F, const In& in, unsigned char* ws) {
    LAS float* scr = (LAS float*)(F.lds + RING_OFF + F.wave * 16384);
    const int gw = F.vcu * NWAVES + F.wave, NGW = F.G * NWAVES;
    constexpr int I_GU = (DM / 64) * (DFF / 32), I_D = (DFF / 64) * (DM / 32), I_IN = (DM / 64) * (NIN / 32), I_O = (DM / 64) * (DM / 32);
    constexpr int NITEMS = 4 * I_GU + 2 * I_D + I_IN + I_O;
    for (int it = gw; it < NITEMS; it += NGW) {
        int r = it;
        if (r < 4 * I_GU) {
            const int which = r / I_GU; r -= which * I_GU;
            const int nb = r % (DFF / 32), kb = r / (DFF / 32), n0 = 32 * nb;
            const float* W = in.p[which == 0 ? 7 : which == 1 ? 8 : which == 2 ? 21 : 22];
            const float* ln = in.p[which < 2 ? 6 : 20];
            bf16* WT = (bf16*)(ws + (which < 2 ? WS_W1GU : WS_W2GU));
            p0_transpose_item(W, DFF, ln, 64 * kb, n0, WT, DM, (n0 / 128) * 256 + (n0 % 128) + ((which & 1) ? 128 : 0), scr, F.lane, (which & 1) ? -0.6931471805599453f : -1.4426950408889634f);
            continue;
        }
        r -= 4 * I_GU;
        if (r < 2 * I_D) {
            const int which = r / I_D; r -= which * I_D;
            const int nb = r % (DM / 32), kb = r / (DM / 32);
            p0_transpose_item(in.p[which == 0 ? 9 : 23], DM, nullptr, 64 * kb, 32 * nb, (bf16*)(ws + (which == 0 ? WS_W1D : WS_W2D)), DFF, 32 * nb, scr, F.lane);
            continue;
        }
        r -= 2 * I_D;
        if (r < I_IN) { const int nb = r % (NIN / 32), kb = r / (NIN / 32); p0_transpose_item(in.p[11], NIN, in.p[10], 64 * kb, 32 * nb, (bf16*)(ws + WS_WIN), DM, 32 * nb, scr, F.lane); continue; }
        r -= I_IN;
        { const int nb = r % (DM / 32), kb = r / (DM / 32); p0_transpose_item(in.p[19], DM, nullptr, 64 * kb, 32 * nb, (bf16*)(ws + WS_WOUT), DM, 32 * nb, scr, F.lane); }
    }
    for (int e = (F.vcu * NWAVES + F.wave) * 64 + F.lane; e < 2 * 32768; e += NGW * 64) {
        const int which = e >> 15, r = e & 32767, n = r >> 12, d = (r >> 6) & 63, c = r & 63;
        const float v = in.p[which ? 16 : 14][(n * 64 + c) * 64 + d];
        ((bf16*)(ws + (which ? WS_WGX : WS_WGA)))[r] = (bf16)f2bf(v);
    }
    bf16* XB = (bf16*)(ws + WS_XB); float* RI0 = (float*)(ws + WS_RI0);
    for (int m0 = gw; m0 < MROWS; m0 += 8 * NGW) {
        f32x4 v[8][4];
#pragma unroll
        for (int r = 0; r < 8; ++r) {
            const int m = (m0 + r * NGW < MROWS) ? m0 + r * NGW : m0;
            const float* xrow = (m < MP) ? in.p[0] + (size_t)m * DM : in.p[1] + (size_t)(m - MP) * DM;
            const GAS f32x4* xr = (const GAS f32x4*)xrow + F.lane;
#pragma unroll
            for (int j = 0; j < 4; ++j) v[r][j] = xr[64 * j];
        }
#pragma unroll
        for (int r = 0; r < 8; ++r) {
            const int m = m0 + r * NGW;
            float s = 0.f;
#pragma unroll
            for (int j = 0; j < 4; ++j) s += (v[r][j].x * v[r][j].x + v[r][j].y * v[r][j].y) + (v[r][j].z * v[r][j].z + v[r][j].w * v[r][j].w);
            s = rows_sum(sum16(s));
            const float ms = s * (1.0f / DM) + 1e-6f, rs = __builtin_amdgcn_rsqf(ms);
            if (m < MROWS) {
                GAS unsigned long long* o8 = (GAS unsigned long long*)(XB + (size_t)m * DM) + F.lane;
#pragma unroll
                for (int j = 0; j < 4; ++j) o8[64 * j] = (unsigned long long)pk2(v[r][j].x * rs, v[r][j].y * rs) | ((unsigned long long)pk2(v[r][j].z * rs, v[r][j].w * rs) << 32);
                if (F.lane == 0) RI0[m] = ms * rs;
            }
        }
    }
}

typedef short v4i16_t __attribute__((ext_vector_type(4)));
typedef unsigned u32x2_t __attribute__((ext_vector_type(2)));
__device__ __forceinline__ v4i16_t vtr(const LAS unsigned char* p) { return __builtin_amdgcn_ds_read_tr16_b64_v4i16((LAS v4i16_t*)p); }
constexpr int ATT_V = 32768, ATT_BUF = 65536;
__device__ __forceinline__ void glds16(const void* gsrc, unsigned lds_dst) {
    unsigned keep;
    asm volatile("s_mov_b32 %0, m0\n\ts_mov_b32 m0, %2\n\ts_nop 0\n\tglobal_load_lds_dwordx4 %1, off\n\ts_mov_b32 m0, %0" : "=&s"(keep) : "v"(gsrc), "s"(lds_dst) : "memory");
}
struct UnitP { int tok0, dil, s, rho; };
__device__ __forceinline__ UnitP unit_params(int k, int S2) {
    UnitP u; const int br = k >> 4, lb = k & 15;
    if (br == 0) { u.s = S2 * 16 + lb; u.rho = 0; u.dil = 1; u.tok0 = (u.s - 1) * 128; }
    else if (br == 1) { u.s = S2 * 4 + (lb >> 2); u.rho = lb & 3; u.dil = 4; u.tok0 = (u.s - 1) * 512 + u.rho; }
    else { u.s = S2; u.rho = lb; u.dil = 16; u.tok0 = (S2 - 1) * 2048 + lb; }
    return u;
}
__device__ __forceinline__ void attn_dma(unsigned ldsb, const bf16* Kg, const bf16* Vg, int rowbase, int h, const UnitP& u, int wave, int lane) {
    const int slot = lane & 7, lr = lane >> 3;
    const int lc = (((slot >> 1) ^ ((lr >> 1) & 3)) << 1) | ((slot ^ lr) & 1);
#pragma unroll
    for (int i = 0; i < 4; ++i) {
        const int p = wave + 8 * i, row = 8 * p + lr;
        int tok = u.tok0 + row * u.dil; tok = tok < 0 ? 0 : tok;
        const size_t off = ((((size_t)(rowbase >> 13) * 8 + h) * 16 + (tok & 15)) * 512 + (tok >> 4)) * 64 + lc * 8;
        const unsigned dst = (unsigned)__builtin_amdgcn_readfirstlane((int)(ldsb + p * 1024));
        glds16(Kg + off, dst); glds16(Vg + off, dst + ATT_V);
    }
}
template <int BR>
__device__ __forceinline__ void attn_compute(const LAS unsigned char* lds, bf16x8 q0, bf16x8 q1, bf16* PO, float* PL, int rowbase, int h, int s, int rho, int wave, int lane,
                                             u32x2_t (&ow)[4], float& olse, bf16*& optr, float*& olptr) {
    constexpr int dil = BR == 0 ? 1 : BR == 1 ? 4 : 16, span = 128 * dil;
    const int ii = lane & 15, g = lane >> 4, w = wave;
    const int tq = s * span + rho + (16 * w + ii) * dil;
    const size_t qrow = (size_t)(rowbase + tq);
    const int xk = (ii >> 1) & 3;
    const LAS unsigned char* kbase = lds + ((16 * w + ii) * 128 + ((g ^ ii) & 1) * 16);
    const LAS unsigned char* kb0 = kbase + ((((g >> 1)) ^ xk) << 5); const LAS unsigned char* kb1 = kbase + ((((g >> 1) + 2) ^ xk) << 5);
    f32x4 sc[9];
    {
        bf16x8 kf0[9], kf1[9];
#pragma unroll
        for (int kt = 0; kt < 9; ++kt) { kf0[kt] = *(const LAS bf16x8*)(kb0 + kt * 2048); kf1[kt] = *(const LAS bf16x8*)(kb1 + kt * 2048); }
        __builtin_amdgcn_sched_barrier(0);
#pragma unroll
        for (int kt = 0; kt < 9; ++kt) sc[kt] = __builtin_amdgcn_mfma_f32_16x16x32_bf16(kf0[kt], q0, (f32x4){0.f, 0.f, 0.f, 0.f}, 0, 0, 0);
#pragma unroll
        for (int kt = 0; kt < 9; ++kt) sc[kt] = __builtin_amdgcn_mfma_f32_16x16x32_bf16(kf1[kt], q1, sc[kt], 0, 0, 0);
    }
    const int qv = ii >> 2, pp = ii & 3, xv = (2 * g + (qv >> 1)) & 3;
    const LAS unsigned char* vbase = lds + ATT_V + ((16 * w + 4 * g + qv) * 128 + 8 * (pp ^ ((qv & 1) << 1)));
    v4i16_t vlo[5][4], vhi[5][4];
#pragma unroll
    for (int p = 0; p < 5; ++p)
#pragma unroll
        for (int db = 0; db < 4; ++db) { const LAS unsigned char* vb = vbase + ((db ^ xv) << 5) + p * 4096; vlo[p][db] = vtr(vb); vhi[p][db] = vtr(vb + (p < 4 ? 2048 : 0)); }
    __builtin_amdgcn_sched_barrier(0);
    const float NEG = -INFINITY;
#pragma unroll
    for (int r = 0; r < 4; ++r) { if (4 * g + r < ii) sc[0][r] = NEG; if (4 * g + r > ii) sc[8][r] = NEG; }
    if (s == 0) {
#pragma unroll
        for (int kt = 0; kt < 8; ++kt)
#pragma unroll
            for (int r = 0; r < 4; ++r) if (16 * w + 16 * kt + 4 * g + r < 128) sc[kt][r] = NEG;
    }
    float mx = NEG;
#pragma unroll
    for (int kt = 0; kt < 9; ++kt) mx = fmaxf(mx, fmaxf(fmaxf(sc[kt][0], sc[kt][1]), fmaxf(sc[kt][2], sc[kt][3])));
    mx = rows_max(mx);
    float ls = 0.f;
#pragma unroll
    for (int kt = 0; kt < 9; ++kt)
#pragma unroll
        for (int r = 0; r < 4; ++r) { const float p = __builtin_amdgcn_exp2f(sc[kt][r] - mx); sc[kt][r] = p; ls += p; }
    ls = rows_sum(ls);
    f32x4 o[4];
#pragma unroll
    for (int db = 0; db < 4; ++db) o[db] = (f32x4){0.f, 0.f, 0.f, 0.f};
#pragma unroll
    for (int p = 0; p < 5; ++p) {
        pg8::u32x4 pw;
        pw.x = pg8::cvt_pk_bf16(sc[2 * p][0], sc[2 * p][1]); pw.y = pg8::cvt_pk_bf16(sc[2 * p][2], sc[2 * p][3]);
        if (p < 4) { pw.z = pg8::cvt_pk_bf16(sc[2 * p + 1][0], sc[2 * p + 1][1]); pw.w = pg8::cvt_pk_bf16(sc[2 * p + 1][2], sc[2 * p + 1][3]); } else { pw.z = 0u; pw.w = 0u; }
        const bf16x8 pb = __builtin_bit_cast(bf16x8, pw);
#pragma unroll
        for (int db = 0; db < 4; ++db) {
            const v4i16_t lo = vlo[p][db], hi = vhi[p][db];
            const bf16x8 va = (bf16x8){lo[0], lo[1], lo[2], lo[3], hi[0], hi[1], hi[2], hi[3]};
            o[db] = __builtin_amdgcn_mfma_f32_16x16x32_bf16(va, pb, o[db], 0, 0, 0);
        }
    }
    const float linv = __builtin_amdgcn_rcpf(ls);
    const float lse = mx + __builtin_amdgcn_logf(ls);
    optr = PO + (size_t)BR * ((size_t)MP * 512) + qrow * 512 + h * 64 + 4 * g;
#pragma unroll
    for (int db = 0; db < 4; ++db) { ow[db].x = pg8::cvt_pk_bf16(o[db][0] * linv, o[db][1] * linv); ow[db].y = pg8::cvt_pk_bf16(o[db][2] * linv, o[db][3] * linv); }
    olse = lse; olptr = PL + (size_t)BR * ((size_t)MP * 8) + qrow * 8 + h;
}
#define ATT_TOP_WAIT(N) asm volatile("s_waitcnt vmcnt(" #N ") lgkmcnt(0)\n\ts_barrier" ::: "memory")
struct AUnit { int b, h, s, rho, dil, tok0; };
__device__ __forceinline__ AUnit aunit(int xcd, int j, int pp, int i) {
    AUnit u; const int bh = xcd + 8 * pp, v = (j + 32 * i) & 63, br = i >> 1;
    u.b = bh >> 3; u.h = bh & 7;
    if (br == 0) { u.dil = 1; u.s = v; u.rho = 0; u.tok0 = (v - 1) * 128; }
    else if (br == 1) { u.dil = 4; u.s = v >> 2; u.rho = v & 3; u.tok0 = (u.s - 1) * 512 + u.rho; }
    else { u.dil = 16; u.s = v >> 4; u.rho = v & 15; u.tok0 = (u.s - 1) * 2048 + u.rho; }
    return u;
}
__device__ __forceinline__ void attn_units(Frame& F, unsigned char* ws) {
    const int xcd = (F.vcu >> 5) & 7, j = F.vcu & 31;
    const bf16* Qg = (const bf16*)(ws + WS_Z); const bf16* Kg = Qg + (size_t)MROWS * 512; const bf16* Vg = Kg + (size_t)MROWS * 512;
    bf16* PO = (bf16*)(ws + WS_PO); float* PL = (float*)(ws + WS_PL);
    const LAS unsigned char* lds = F.lds + RING_OFF;
    const unsigned ldsb = (unsigned)(uintptr_t)(F.lds + RING_OFF);
    const int ii = F.lane & 15, g = F.lane >> 4;
    const LAS unsigned char* qw = F.lds + QBUF_OFF + F.wave * 2048;
    const unsigned qwb = (unsigned)__builtin_amdgcn_readfirstlane((int)(unsigned)(uintptr_t)qw);
    const unsigned wwb = (unsigned)__builtin_amdgcn_readfirstlane((int)(unsigned)(uintptr_t)(F.lds + WARM_OFF + F.wave * 256));
#define ATT_QDMA(U) do { _Pragma("unroll") for (int j_ = 0; j_ < 2; ++j_) { const int tq_ = (U).s * 128 * (U).dil + (U).rho + (16 * F.wave + 8 * j_ + (F.lane >> 3)) * (U).dil; \
        glds16(Qg + (size_t)((U).b * SEQ + tq_) * 512 + (U).h * 64 + ((F.lane ^ (F.lane >> 3)) & 7) * 8, qwb + j_ * 1024); } } while (0)
#define ATT_QREAD() do { q0 = *(const LAS bf16x8*)(qw + ii * 128 + 16 * (g ^ (ii & 7))); q1 = *(const LAS bf16x8*)(qw + ii * 128 + 16 * ((4 + g) ^ (ii & 7))); LDS_WAIT(); } while (0)
#define ATT_WARM(U) do { const int tq_ = (U).s * 128 * (U).dil + (U).rho + (16 * F.wave + ii) * (U).dil; const bf16* wp_ = Qg + (size_t)((U).b * SEQ + tq_) * 512 + (U).h * 64 + g * 16; unsigned keep_; \
        asm volatile("s_mov_b32 %0, m0\n\ts_mov_b32 m0, %2\n\ts_nop 0\n\tglobal_load_lds_dword %1, off\n\ts_mov_b32 m0, %0" : "=&s"(keep_) : "v"(wp_), "s"(wwb) : "memory"); } while (0)
#define ATT_DMA(U, BUF) do { UnitP up_; up_.tok0 = (U).tok0; up_.dil = (U).dil; up_.s = (U).s; up_.rho = (U).rho; attn_dma(ldsb + (BUF) * ATT_BUF, Kg, Vg, (U).b * SEQ, (U).h, up_, F.wave, F.lane); } while (0)
#define ATT_UNIT(NK) aunit(xcd, j, (NK) / 6, (NK) % 6)
    AUnit u = ATT_UNIT(0), un = u;
    bf16x8 q0, q1;
    u32x2_t pw[4]; float plse = 0.f; bf16* pptr = nullptr; float* plptr = nullptr;
#pragma unroll
    for (int db = 0; db < 4; ++db) pw[db] = (u32x2_t){0u, 0u};
#define ATT_FLUSH() do { if (pptr) { _Pragma("unroll") for (int db_ = 0; db_ < 4; ++db_) *(u32x2_t*)(pptr + 16 * db_) = pw[db_]; if (g == 0) *plptr = plse; pptr = nullptr; } } while (0)
    ATT_QDMA(u); ATT_DMA(u, 0); { const AUnit uw_ = ATT_UNIT(1); ATT_WARM(uw_); }
#define ATT_STEP(BR, K) do { \
        ATT_TOP_WAIT(1); \
        ATT_QREAD(); \
        ATT_FLUSH(); \
        { const int nk_ = (K) + 1; if (nk_ < 48) { un = ATT_UNIT(nk_); ATT_DMA(un, nk_ & 1); ATT_QDMA(un); } \
          const int wk_ = nk_ + 1 < 48 ? nk_ + 1 : 47; const AUnit uw_ = ATT_UNIT(wk_); ATT_WARM(uw_); } \
        attn_compute<BR>(lds + ((K) & 1) * ATT_BUF, q0, q1, PO, PL, u.b * SEQ, u.h, u.s, u.rho, F.wave, F.lane, pw, plse, pptr, plptr); \
        u = un; } while (0)
#pragma unroll 1
    for (int pp = 0; pp < 8; ++pp) {
#pragma unroll 1
        for (int e = 0; e < 2; ++e) ATT_STEP(0, 6 * pp + e);
#pragma unroll 1
        for (int e = 2; e < 4; ++e) ATT_STEP(1, 6 * pp + e);
#pragma unroll 1
        for (int e = 4; e < 6; ++e) ATT_STEP(2, 6 * pp + e);
    }
    ATT_FLUSH();
    VM_WAIT(); LDS_WAIT(); __builtin_amdgcn_s_barrier(); asm volatile("" ::: "memory");
#undef ATT_STEP
#undef ATT_FLUSH
#undef ATT_UNIT
#undef ATT_DMA
#undef ATT_WARM
#undef ATT_QREAD
#undef ATT_QDMA
}
__device__ __forceinline__ void attn_merge(Frame& F, unsigned char* ws) {
    const bf16* PO = (const bf16*)(ws + WS_PO); const float* PL = (const float*)(ws + WS_PL); bf16* MIX = (bf16*)(ws + WS_MIX);
    const int NT = F.G * NWAVES * 64, gt = (F.vcu * NWAVES + F.wave) * 64 + F.lane;
#pragma unroll 4
    for (int idx = gt; idx < MP * 64; idx += NT) {
        const size_t qrow = (size_t)(idx >> 6); const int h = (idx >> 3) & 7, dg = (idx & 7) * 8;
        const float l0 = PL[qrow * 8 + h], l1 = PL[(size_t)MP * 8 + qrow * 8 + h], l2 = PL[(size_t)2 * MP * 8 + qrow * 8 + h];
        const v4u a = *(const v4u*)(PO + qrow * 512 + h * 64 + dg), bb = *(const v4u*)(PO + (size_t)MP * 512 + qrow * 512 + h * 64 + dg), c = *(const v4u*)(PO + (size_t)2 * MP * 512 + qrow * 512 + h * 64 + dg);
        const float mm = fmaxf(fmaxf(l0, l1), l2);
        const float w0 = __builtin_amdgcn_exp2f(l0 - mm), w1 = __builtin_amdgcn_exp2f(l1 - mm), w2 = __builtin_amdgcn_exp2f(l2 - mm);
        const float wi = __builtin_amdgcn_rcpf(w0 + w1 + w2), c0 = w0 * wi, c1 = w1 * wi, c2 = w2 * wi;
#define ATT_MRG(F_) pg8::cvt_pk_bf16(c0 * __builtin_bit_cast(float, a.F_ << 16) + c1 * __builtin_bit_cast(float, bb.F_ << 16) + c2 * __builtin_bit_cast(float, c.F_ << 16), \
                                     c0 * __builtin_bit_cast(float, a.F_ & 0xffff0000u) + c1 * __builtin_bit_cast(float, bb.F_ & 0xffff0000u) + c2 * __builtin_bit_cast(float, c.F_ & 0xffff0000u))
        v4u o; o.x = ATT_MRG(x); o.y = ATT_MRG(y); o.z = ATT_MRG(z); o.w = ATT_MRG(w);
#undef ATT_MRG
        *(v4u*)(MIX + qrow * 1024 + h * 64 + dg) = o;
    }
}
__device__ __forceinline__ void attn_sample_item(LAS unsigned char* wl, const In& in, unsigned char* ws, float* outp, int b, int h, int t, int lane) {
    const int i = lane & 15, g = lane >> 4;
    const bf16* Qg = (const bf16*)(ws + WS_Z);
    const size_t srow = (size_t)MP + b * DECT + t;
    const u32x2_t qw = *(const u32x2_t*)(Qg + srow * 512 + h * 64 + 4 * i);
    const float q0 = __builtin_bit_cast(float, qw.x << 16), q1 = __builtin_bit_cast(float, qw.x & 0xffff0000u), q2 = __builtin_bit_cast(float, qw.y << 16), q3 = __builtin_bit_cast(float, qw.y & 0xffff0000u);
    const float* ckb = in.p[2] + (size_t)b * WBUF * 512 + h * 64; const float* cvb = in.p[3] + (size_t)b * WBUF * 512 + h * 64;
    const float* nk = outp + O_KNS + (size_t)b * DECT * 512 + h * 64; const float* nv = outp + O_VNS + (size_t)b * DECT * 512 + h * 64;
    float m = -1e30f, l = 0.f; f32x4 o = (f32x4){0.f, 0.f, 0.f, 0.f};
    {
        const int cnt = t + 3 + (t >= 4 ? 1 : 0);
        float scn[3]; f32x4 vn[3];
#pragma unroll
        for (int it = 0; it < 3; ++it) {
            const int e = 4 * it + g; int tp = (e <= t) ? t - e : (e == t + 3 ? t - 4 : t); tp = tp < 0 ? 0 : tp;
            const unsigned off = (unsigned)(tp * 512 + 4 * i);
            const f32x4 kv = *(const f32x4*)(nk + off); vn[it] = *(const f32x4*)(nv + off);
            const float s = sum16((q0 * kv[0] + q1 * kv[1]) + (q2 * kv[2] + q3 * kv[3]));
            scn[it] = (e < cnt) ? s : -INFINITY;
        }
        m = fmaxf(m, fmaxf(scn[0], fmaxf(scn[1], scn[2])));
#pragma unroll
        for (int it = 0; it < 3; ++it) { const float p = __builtin_amdgcn_exp2f(scn[it] - m); l += p; o = o + vn[it] * p; }
    }
#define S_SRC(PI, BASE) ({ const int pi_ = (PI) > 98 ? 98 : (PI); const int br_ = pi_ >= 66 ? 2 : (pi_ >= 33 ? 1 : 0); const int j_ = 4 * (pi_ - 33 * br_) + g; \
        int idx_ = WBUF + t - (j_ << (2 * br_)); idx_ = idx_ < 0 ? 0 : (idx_ >= WBUF ? WBUF - 1 : idx_); (BASE) + (unsigned)(idx_ * 512 + 4 * i); })
    const unsigned wlb = (unsigned)__builtin_amdgcn_readfirstlane((int)(unsigned)(uintptr_t)wl);
#pragma unroll
    for (int n = 0; n < 8; ++n) { glds16(S_SRC(n, ckb), wlb + n * 2048); glds16(S_SRC(n, cvb), wlb + n * 2048 + 1024); }
#pragma unroll 1
    for (int pi = 0; pi < 99; ++pi) {
        asm volatile("s_waitcnt vmcnt(14)" ::: "memory");
        const int sb = (pi & 7) * 2048;
        const f32x4 kv = *(const LAS f32x4*)(wl + sb + lane * 16), vv = *(const LAS f32x4*)(wl + sb + 1024 + lane * 16);
        LDS_WAIT();
        glds16(S_SRC(pi + 8, ckb), wlb + sb); glds16(S_SRC(pi + 8, cvb), wlb + sb + 1024);
        const int br = pi >= 66 ? 2 : (pi >= 33 ? 1 : 0), j = 4 * (pi - 33 * br) + g;
        float sv = sum16((q0 * kv[0] + q1 * kv[1]) + (q2 * kv[2] + q3 * kv[3]));
        if (j > 128 || (j << (2 * br)) <= t) sv = -INFINITY;
        const float mn = fmaxf(m, sv), f = __builtin_amdgcn_exp2f(m - mn), pv = __builtin_amdgcn_exp2f(sv - mn);
        l = l * f + pv; o = o * f + vv * pv; m = mn;
    }
    asm volatile("s_waitcnt vmcnt(0)" ::: "memory");
#undef S_SRC
    const float mm = rows_max(m);
    const float f = __builtin_amdgcn_exp2f(m - mm);
    l = rows_sum(l * f);
#pragma unroll
    for (int e = 0; e < 4; ++e) o[e] = rows_sum(o[e] * f);
    if (g == 0) {
        const float li = __builtin_amdgcn_rcpf(l);
        u32x2_t wv; wv.x = pg8::cvt_pk_bf16(o[0] * li, o[1] * li); wv.y = pg8::cvt_pk_bf16(o[2] * li, o[3] * li);
        *(u32x2_t*)((bf16*)(ws + WS_MIX) + srow * 1024 + h * 64 + 4 * i) = wv;
    }
}

constexpr int RW_BYTES = 16384, RW_XCB_PITCH = 144, RW_PITCH = 68;
constexpr int RW_XCF = 16 * RW_XCB_PITCH, RW_AL = RW_XCF + 16 * RW_PITCH * 4, RW_BL = RW_AL + 16 * RW_PITCH * 4;
static_assert(RW_BL + 16 * RW_PITCH * 4 <= RW_BYTES && NWAVES * RW_BYTES <= RING_BYTES, "rnn LDS");
template <bool PASS2>
__device__ __forceinline__ void rnn_wave_item(LAS unsigned char* wl, const In& in, unsigned char* ws, int n, size_t row0, int ntok, float hu3, float hu2, float hu1, float h0, float& ra, float& rb, float (&hu)[3], int lane) {
    const bf16* Ub = (const bf16*)(ws + WS_Z) + (size_t)3 * MROWS * 512 + 64 * n + lane; const bf16* Gb = Ub + (size_t)MROWS * 512;
    bf16* MIX = (bf16*)(ws + WS_MIX) + 512 + 64 * n + lane;
    const int ch = 64 * n + lane, i = lane & 15, g = lane >> 4;
    const float cw0 = in.p[12][ch], cw1 = in.p[12][512 + ch], cw2 = in.p[12][1024 + ch], cw3 = in.p[12][1536 + ch], cb = in.p[13][ch];
    float ba[4], bx[4], sp8[4]; bf16x8 wa[4][2], wx[4][2];
    const bf16* WA = (const bf16*)(ws + WS_WGA) + n * 4096; const bf16* WX = (const bf16*)(ws + WS_WGX) + n * 4096;
#pragma unroll
    for (int db = 0; db < 4; ++db) {
        const int c = 64 * n + 16 * db + i;
        ba[db] = in.p[15][c]; bx[db] = in.p[17][c];
        sp8[db] = 8.0f * log1pf(expf(-in.p[18][c]));
#pragma unroll
        for (int ks = 0; ks < 2; ++ks) { wa[db][ks] = *(const bf16x8*)(WA + (16 * db + i) * 64 + 8 * g + 32 * ks); wx[db][ks] = *(const bf16x8*)(WX + (16 * db + i) * 64 + 8 * g + 32 * ks); }
    }
    float u3 = hu3, u2 = hu2, u1 = hu1, h = h0, P = 1.0f;
    LAS float* XCF = (LAS float*)(wl + RW_XCF); LAS float* AL = (LAS float*)(wl + RW_AL); LAS float* BL = (LAS float*)(wl + RW_BL);
    const int nsub = (ntok + 15) >> 4;
    unsigned short uraw[16], graw[16];
#pragma unroll
    for (int tt = 0; tt < 16; ++tt) { uraw[tt] = (tt < ntok) ? Ub[(row0 + tt) * 512] : (unsigned short)0; graw[tt] = (PASS2 && tt < ntok) ? Gb[(row0 + tt) * 512] : (unsigned short)0; }
    for (int sb = 0; sb < nsub; ++sb) {
        const int nv = (ntok - 16 * sb) < 16 ? (ntok - 16 * sb) : 16;
        const size_t r0 = row0 + 16 * sb;
        unsigned short unx[16], gnx[16];
        const bool more = (sb + 1 < nsub);
#pragma unroll
        for (int tt = 0; tt < 16; ++tt) { unx[tt] = more ? Ub[(r0 + 16 + tt) * 512] : (unsigned short)0; gnx[tt] = (PASS2 && more) ? Gb[(r0 + 16 + tt) * 512] : (unsigned short)0; }
#pragma unroll
        for (int tt = 0; tt < 16; ++tt) {
            float xc = 0.f;
            if (tt < nv) { const float u0 = bf2f(uraw[tt]); xc = cb + cw0 * u3 + cw1 * u2 + cw2 * u1 + cw3 * u0; u3 = u2; u2 = u1; u1 = u0; }
            XCF[tt * RW_PITCH + lane] = xc;
            *(LAS unsigned short*)(wl + tt * RW_XCB_PITCH + lane * 2) = (unsigned short)f2bf(xc);
        }
        LDS_WAIT(); asm volatile("" ::: "memory");
        {
            const bf16x8 a0 = *(const LAS bf16x8*)(wl + i * RW_XCB_PITCH + 16 * g), a1 = *(const LAS bf16x8*)(wl + i * RW_XCB_PITCH + 16 * g + 64);
#pragma unroll
            for (int db = 0; db < 4; ++db) {
                f32x4 da = (f32x4){0.f, 0.f, 0.f, 0.f}, dx = (f32x4){0.f, 0.f, 0.f, 0.f};
                da = __builtin_amdgcn_mfma_f32_16x16x32_bf16(a0, wa[db][0], da, 0, 0, 0); da = __builtin_amdgcn_mfma_f32_16x16x32_bf16(a1, wa[db][1], da, 0, 0, 0);
                dx = __builtin_amdgcn_mfma_f32_16x16x32_bf16(a0, wx[db][0], dx, 0, 0, 0); dx = __builtin_amdgcn_mfma_f32_16x16x32_bf16(a1, wx[db][1], dx, 0, 0, 0);
                const int c = 16 * db + i;
#pragma unroll
                for (int r = 0; r < 4; ++r) {
                    const int tok = 4 * g + r;
                    const float xcv = XCF[tok * RW_PITCH + c];
                    const float rg = fsigmoid(da[r] + ba[db]), ig = fsigmoid(dx[r] + bx[db]);
                    const float log_a = -rg * sp8[db];
                    const float a = __builtin_amdgcn_exp2f(1.4426950408889634f * log_a);
                    const float x2 = 2.0f * log_a;
                    const float em = (x2 > -0.0625f) ? -x2 * (1.0f + x2 * (0.5f + x2 * (0.16666667f + x2 * (0.041666668f + x2 * 0.0083333338f)))) : (1.0f - a * a);
                    const float bt = __builtin_amdgcn_sqrtf(em) * ig * xcv;
                    AL[tok * RW_PITCH + c] = a; BL[tok * RW_PITCH + c] = bt;
                }
            }
        }
        LDS_WAIT(); asm volatile("" ::: "memory");
        if (PASS2) {
#pragma unroll
            for (int tt = 0; tt < 16; ++tt) if (tt < nv) {
                h = AL[tt * RW_PITCH + lane] * h + BL[tt * RW_PITCH + lane];
                const float gv = bf2f(graw[tt]);
                const float z2 = 1.5957691216057308f * (gv + 0.044715f * gv * gv * gv);
                MIX[(r0 + tt) * 1024] = (bf16)f2bf(h * gv * fsigmoid(z2));
            }
        } else {
#pragma unroll
            for (int tt = 0; tt < 16; ++tt) if (tt < nv) { const float a = AL[tt * RW_PITCH + lane]; h = a * h + BL[tt * RW_PITCH + lane]; P *= a; }
        }
        LDS_WAIT(); asm volatile("" ::: "memory");
#pragma unroll
        for (int tt = 0; tt < 16; ++tt) { uraw[tt] = unx[tt]; graw[tt] = gnx[tt]; }
    }
    ra = P; rb = h; hu[0] = u3; hu[1] = u2; hu[2] = u1;
}

template <bool BB, bool OF, bool OB>
__device__ __forceinline__ void sgk_resid(Frame& F, const bf16* A, int K, const bf16* Wt, const float* xs  , bf16* XB, float* outf, float* ss, float alpha) {
    const int i = F.lane & 15, g = F.lane >> 4, w = F.wave;
    LAS float* part = (LAS float*)(F.lds + RING_OFF);
    const int Ks = K >> 3, nsteps = Ks >> 5;
    for (int tile = F.vcu; tile < (MS / 64) * (DM / 64); tile += F.G) {
        const int rt = tile >> 4, ct = tile & 15, arow0 = MP + rt * 64, c0 = ct * 64;
        f32x4 acc[4][4];
#pragma unroll
        for (int bq = 0; bq < 4; ++bq)
#pragma unroll
            for (int ar = 0; ar < 4; ++ar) acc[bq][ar] = (f32x4){0.f, 0.f, 0.f, 0.f};
        const bf16* ap = A + (size_t)(arow0 + i) * K + w * Ks + 8 * g;
        const bf16* bp = Wt + (size_t)(c0 + i) * K + w * Ks + 8 * g;
#pragma unroll 1
        for (int s0 = 0; s0 < nsteps; s0 += 4) {
            bf16x8 fa[4][4], fb[4][4];
#pragma unroll
            for (int st = 0; st < 4; ++st) {
                const int step = (s0 + st < nsteps) ? s0 + st : nsteps - 1;
#pragma unroll
                for (int q = 0; q < 4; ++q) { fa[st][q] = *(const bf16x8*)(ap + (size_t)q * 16 * K + 32 * step); fb[st][q] = *(const bf16x8*)(bp + (size_t)q * 16 * K + 32 * step); }
            }
            __builtin_amdgcn_sched_barrier(0);
#pragma unroll
            for (int st = 0; st < 4; ++st) if (s0 + st < nsteps) {
#pragma unroll
                for (int bq = 0; bq < 4; ++bq)
#pragma unroll
                    for (int ar = 0; ar < 4; ++ar) acc[bq][ar] = __builtin_amdgcn_mfma_f32_16x16x32_bf16(fb[st][bq], fa[st][ar], acc[bq][ar], 0, 0, 0);
            }
        }
#pragma unroll
        for (int bq = 0; bq < 4; ++bq)
#pragma unroll
            for (int ar = 0; ar < 4; ++ar) *(LAS f32x4*)(part + ((w * 64 + 16 * ar + i) * 64 + 16 * bq + 4 * g)) = acc[bq][ar];
        __syncthreads();
        {
            const int row = F.tid >> 3, c8 = (F.tid & 7) * 8, grow = arow0 + row, col = c0 + c8;
            f32x4 s0v = (f32x4){0.f, 0.f, 0.f, 0.f}, s1v = s0v;
#pragma unroll
            for (int ww = 0; ww < 8; ++ww) { const LAS f32x4* pp = (const LAS f32x4*)(part + ((ww * 64 + row) * 64 + c8)); s0v = s0v + pp[0]; s1v = s1v + pp[1]; }
            const size_t off = (size_t)grow * DM + col;
            f32x4 b0, b1;
            if (BB) { const v4u wv = *(const v4u*)(XB + off);
                b0 = (f32x4){__builtin_bit_cast(float, wv.x << 16), __builtin_bit_cast(float, wv.x & 0xffff0000u), __builtin_bit_cast(float, wv.y << 16), __builtin_bit_cast(float, wv.y & 0xffff0000u)};
                b1 = (f32x4){__builtin_bit_cast(float, wv.z << 16), __builtin_bit_cast(float, wv.z & 0xffff0000u), __builtin_bit_cast(float, wv.w << 16), __builtin_bit_cast(float, wv.w & 0xffff0000u)}; }
            else { const f32x4* xp = (const f32x4*)(xs + (size_t)(grow - MP) * DM + col); b0 = xp[0]; b1 = xp[1]; }
            const f32x4 o0 = b0 + s0v * alpha, o1 = b1 + s1v * alpha;
            if (OF) { *(f32x4*)(outf + off) = o0; *(f32x4*)(outf + off + 4) = o1; }
            if (OB) { v4u wv; wv.x = pg8::cvt_pk_bf16(o0[0], o0[1]); wv.y = pg8::cvt_pk_bf16(o0[2], o0[3]); wv.z = pg8::cvt_pk_bf16(o1[0], o1[1]); wv.w = pg8::cvt_pk_bf16(o1[2], o1[3]); *(v4u*)(XB + off) = wv; }
            float q = ((o0[0] * o0[0] + o0[1] * o0[1]) + (o0[2] * o0[2] + o0[3] * o0[3])) + ((o1[0] * o1[0] + o1[1] * o1[1]) + (o1[2] * o1[2] + o1[3] * o1[3]));
            q += dppmov<0xB1>(q); q += dppmov<0x4E>(q); q += dppmov<0x141>(q);
            if ((F.tid & 7) == 0) ss[(size_t)grow * 16 + ct] = q;
        }
        __syncthreads();
    }
}

constexpr int PT_OFF = QBUF_OFF;
static_assert(MISC_OFF + 128 <= LDS_BYTES, "LDS map");

__device__ __forceinline__ void phase_0(Frame& F, const In& in, unsigned char* ws, float* outp) {
    bf16* XB = (bf16*)(ws + WS_XB); bf16* HB = (bf16*)(ws + WS_H); bf16* ZB = (bf16*)(ws + WS_Z); bf16* MIXB = (bf16*)(ws + WS_MIX);
    float* SS0 = (float*)(ws + WS_SS0); float* SS1 = (float*)(ws + WS_SS1); float* SS2 = (float*)(ws + WS_SS2); float* SS3 = (float*)(ws + WS_SS3);
    (void)XB; (void)HB; (void)ZB; (void)MIXB; (void)SS0; (void)SS1; (void)SS2; (void)SS3;
        p0_prologue(F, in, ws);
}
__device__ __forceinline__ void phase_1(Frame& F, const In& in, unsigned char* ws, float* outp) {
    bf16* XB = (bf16*)(ws + WS_XB); bf16* HB = (bf16*)(ws + WS_H); bf16* ZB = (bf16*)(ws + WS_Z); bf16* MIXB = (bf16*)(ws + WS_MIX);
    float* SS0 = (float*)(ws + WS_SS0); float* SS1 = (float*)(ws + WS_SS1); float* SS2 = (float*)(ws + WS_SS2); float* SS3 = (float*)(ws + WS_SS3);
    (void)XB; (void)HB; (void)ZB; (void)MIXB; (void)SS0; (void)SS1; (void)SS2; (void)SS3;
        pg8::Gemm g{XB, (const bf16*)(ws + WS_W1GU), MROWS, NGU, DM}; pg8::StaticOrder S; S.init(MROWS, NGU, F.G, (int)blockIdx.x);
        pg8::EpiSwiGLU<false> E{HB, nullptr, DFF, nullptr};
        pg8::gemm_phase<pg8::EpiSwiGLU<false>, pg8::StaticOrder, true, true>(F.lds + RING_OFF, g, S, E);
}
__device__ __forceinline__ void phase_2(Frame& F, const In& in, unsigned char* ws, float* outp) {
    bf16* XB = (bf16*)(ws + WS_XB); bf16* HB = (bf16*)(ws + WS_H); bf16* ZB = (bf16*)(ws + WS_Z); bf16* MIXB = (bf16*)(ws + WS_MIX);
    float* SS0 = (float*)(ws + WS_SS0); float* SS1 = (float*)(ws + WS_SS1); float* SS2 = (float*)(ws + WS_SS2); float* SS3 = (float*)(ws + WS_SS3);
    (void)XB; (void)HB; (void)ZB; (void)MIXB; (void)SS0; (void)SS1; (void)SS2; (void)SS3;
        pg8::Gemm g{HB, (const bf16*)(ws + WS_W1D), MP, DM, DFF}; pg8::StaticOrder S; S.init(MP, DM, F.G, (int)blockIdx.x);
        pg8::EpiResid<false, false, true, false> E{in.p[0], nullptr, nullptr, XB, SS1, nullptr, 0.5f};
        pg8::gemm_phase<pg8::EpiResid<false, false, true, false>, pg8::StaticOrder, true, true>(F.lds + RING_OFF, g, S, E);
        sgk_resid<false, false, true>(F, HB, DFF, (const bf16*)(ws + WS_W1D), in.p[1], XB, nullptr, SS1, 0.5f);
}
__device__ __forceinline__ void phase_3(Frame& F, const In& in, unsigned char* ws, float* outp) {
    bf16* XB = (bf16*)(ws + WS_XB); bf16* HB = (bf16*)(ws + WS_H); bf16* ZB = (bf16*)(ws + WS_Z); bf16* MIXB = (bf16*)(ws + WS_MIX);
    float* SS0 = (float*)(ws + WS_SS0); float* SS1 = (float*)(ws + WS_SS1); float* SS2 = (float*)(ws + WS_SS2); float* SS3 = (float*)(ws + WS_SS3);
    (void)XB; (void)HB; (void)ZB; (void)MIXB; (void)SS0; (void)SS1; (void)SS2; (void)SS3;
        pg8::Gemm g{XB, (const bf16*)(ws + WS_WIN), MROWS, NIN, DM}; pg8::StaticOrder S; S.init(MROWS, NIN, F.G, (int)blockIdx.x);
        pg8::EpiZ E{ZB, SS1, outp, (LAS float*)(F.lds + PT_OFF)};
        pg8::gemm_phase<pg8::EpiZ, pg8::StaticOrder, true, true>(F.lds + RING_OFF, g, S, E);
}
__device__ __forceinline__ void phase_4(Frame& F, const In& in, unsigned char* ws, float* outp) {
    attn_units(F, ws);
#if defined(DUP_SUB) && DUP_SUB == 2
    attn_units(F, ws);
#endif
    LAS unsigned char* wl = F.lds + RING_OFF + F.wave * RW_BYTES;
    const int ch = 64 * F.wave + F.lane;
    const bf16* Ub = (const bf16*)(ws + WS_Z) + (size_t)3 * MROWS * 512;
    for (int ru = F.vcu; ru < BATCH * NCHUNK; ru += F.G) {
        const int c = ru % NCHUNK, row0 = (ru / NCHUNK) * SEQ + c * 256;
        float h3 = 0.f, h2 = 0.f, h1 = 0.f;
        if (c > 0) { h3 = bf2f(Ub[(size_t)(row0 - 3) * 512 + ch]); h2 = bf2f(Ub[(size_t)(row0 - 2) * 512 + ch]); h1 = bf2f(Ub[(size_t)(row0 - 1) * 512 + ch]); }
        float ra, rb, hu[3];
        rnn_wave_item<false>(wl, in, ws, F.wave, (size_t)row0, 256, h3, h2, h1, 0.f, ra, rb, hu, F.lane);
        ((float*)(ws + WS_RSA))[(size_t)ru * 512 + ch] = ra; ((float*)(ws + WS_RSB))[(size_t)ru * 512 + ch] = rb;
    }
}
__device__ __forceinline__ void phase_5(Frame& F, const In& in, unsigned char* ws, float* outp) {
    attn_merge(F, ws);
    LAS unsigned char* wl = F.lds + RING_OFF + F.wave * RW_BYTES;
    const int ch = 64 * F.wave + F.lane;
    const bf16* Ub = (const bf16*)(ws + WS_Z) + (size_t)3 * MROWS * 512;
#pragma unroll 1
    for (int half_ = 0; half_ < 2; ++half_) {
        const int half = half_ ^ (F.wave & 1);
        if (half == 0) {
            for (int ru = F.vcu; ru < BATCH * NCHUNK + DECB; ru += F.G) {
                float ra, rb, hu[3];
                if (ru < BATCH * NCHUNK) {
                    const int b = ru / NCHUNK, c = ru % NCHUNK, row0 = b * SEQ + c * 256;
                    float h3 = 0.f, h2 = 0.f, h1 = 0.f, h0 = 0.f;
                    if (c > 0) { h3 = bf2f(Ub[(size_t)(row0 - 3) * 512 + ch]); h2 = bf2f(Ub[(size_t)(row0 - 2) * 512 + ch]); h1 = bf2f(Ub[(size_t)(row0 - 1) * 512 + ch]); }
                    const float* RA = (const float*)(ws + WS_RSA) + (size_t)b * NCHUNK * 512 + ch; const float* RB = (const float*)(ws + WS_RSB) + (size_t)b * NCHUNK * 512 + ch;
                    {
                        float fa[NCHUNK - 1], fb[NCHUNK - 1];
#pragma unroll
                        for (int cc = 0; cc < NCHUNK - 1; ++cc) { const int ci = cc < c ? cc : 0; fa[cc] = RA[ci * 512]; fb[cc] = RB[ci * 512]; }
#pragma unroll
                        for (int cc = 0; cc < NCHUNK - 1; ++cc) h0 = cc < c ? fa[cc] * h0 + fb[cc] : h0;
                    }
                    rnn_wave_item<true>(wl, in, ws, F.wave, (size_t)row0, 256, h3, h2, h1, h0, ra, rb, hu, F.lane);
                    if (c == NCHUNK - 1) {
                        outp[O_LHP + b * 512 + ch] = rb;
                        outp[O_LCP + (b * 3 + 0) * 512 + ch] = hu[0]; outp[O_LCP + (b * 3 + 1) * 512 + ch] = hu[1]; outp[O_LCP + (b * 3 + 2) * 512 + ch] = hu[2];
                    }
                } else {
                    const int b = ru - BATCH * NCHUNK, row0 = MP + b * DECT;
                    const float* cs = in.p[5] + (size_t)b * 3 * 512 + ch;
                    rnn_wave_item<true>(wl, in, ws, F.wave, (size_t)row0, DECT, cs[0], cs[512], cs[1024], in.p[4][b * 512 + ch], ra, rb, hu, F.lane);
                    outp[O_LHS + b * 512 + ch] = rb;
                    outp[O_LCS + (b * 3 + 0) * 512 + ch] = hu[0]; outp[O_LCS + (b * 3 + 1) * 512 + ch] = hu[1]; outp[O_LCS + (b * 3 + 2) * 512 + ch] = hu[2];
                }
            }
        } else {
            for (int pr = F.vcu; pr < DECB * NHEAD; pr += F.G) attn_sample_item(wl, in, ws, outp, pr >> 3, F.wave, pr & 7, F.lane);
        }
    }
}
__device__ __forceinline__ void phase_6(Frame& F, const In& in, unsigned char* ws, float* outp) {
    bf16* XB = (bf16*)(ws + WS_XB); bf16* HB = (bf16*)(ws + WS_H); bf16* ZB = (bf16*)(ws + WS_Z); bf16* MIXB = (bf16*)(ws + WS_MIX);
    float* SS0 = (float*)(ws + WS_SS0); float* SS1 = (float*)(ws + WS_SS1); float* SS2 = (float*)(ws + WS_SS2); float* SS3 = (float*)(ws + WS_SS3);
    (void)XB; (void)HB; (void)ZB; (void)MIXB; (void)SS0; (void)SS1; (void)SS2; (void)SS3;
        pg8::Gemm g{MIXB, (const bf16*)(ws + WS_WOUT), MP, DM, DM}; pg8::StaticOrder S; S.init(MP, DM, F.G, (int)blockIdx.x);
        pg8::EpiResid<true, false, true, false> E{nullptr, nullptr, nullptr, XB, SS2, nullptr, 1.0f};
        pg8::gemm_phase<pg8::EpiResid<true, false, true, false>, pg8::StaticOrder, true, true>(F.lds + RING_OFF, g, S, E);
        sgk_resid<true, false, true>(F, MIXB, DM, (const bf16*)(ws + WS_WOUT), nullptr, XB, nullptr, SS2, 1.0f);
}
__device__ __forceinline__ void phase_7(Frame& F, const In& in, unsigned char* ws, float* outp) {
    bf16* XB = (bf16*)(ws + WS_XB); bf16* HB = (bf16*)(ws + WS_H); bf16* ZB = (bf16*)(ws + WS_Z); bf16* MIXB = (bf16*)(ws + WS_MIX);
    float* SS0 = (float*)(ws + WS_SS0); float* SS1 = (float*)(ws + WS_SS1); float* SS2 = (float*)(ws + WS_SS2); float* SS3 = (float*)(ws + WS_SS3);
    (void)XB; (void)HB; (void)ZB; (void)MIXB; (void)SS0; (void)SS1; (void)SS2; (void)SS3;
        pg8::Gemm g{XB, (const bf16*)(ws + WS_W2GU), MROWS, NGU, DM}; pg8::StaticOrder S; S.init(MROWS, NGU, F.G, (int)blockIdx.x);
        pg8::EpiSwiGLU<true> E{HB, SS2, DFF, (LAS float*)(F.lds + PT_OFF)};
        pg8::gemm_phase<pg8::EpiSwiGLU<true>, pg8::StaticOrder, true, true>(F.lds + RING_OFF, g, S, E);
}
__device__ __forceinline__ void phase_8(Frame& F, const In& in, unsigned char* ws, float* outp) {
    bf16* XB = (bf16*)(ws + WS_XB); bf16* HB = (bf16*)(ws + WS_H); bf16* ZB = (bf16*)(ws + WS_Z); bf16* MIXB = (bf16*)(ws + WS_MIX);
    float* SS0 = (float*)(ws + WS_SS0); float* SS1 = (float*)(ws + WS_SS1); float* SS2 = (float*)(ws + WS_SS2); float* SS3 = (float*)(ws + WS_SS3);
    (void)XB; (void)HB; (void)ZB; (void)MIXB; (void)SS0; (void)SS1; (void)SS2; (void)SS3;
        pg8::Gemm g{HB, (const bf16*)(ws + WS_W2D), MP, DM, DFF}; pg8::StaticOrder S; S.init(MP, DM, F.G, (int)blockIdx.x);
        pg8::EpiResid<true, true, false, false> E{nullptr, nullptr, outp + O_Y, XB, SS3, nullptr, 0.5f};
        pg8::gemm_phase<pg8::EpiResid<true, true, false, false>, pg8::StaticOrder, true, true>(F.lds + RING_OFF, g, S, E);
        sgk_resid<true, true, false>(F, HB, DFF, (const bf16*)(ws + WS_W2D), nullptr, XB, outp + O_Y, SS3, 0.5f);
}
__device__ __forceinline__ void phase_9(Frame& F, const In& in, unsigned char* ws, float* outp) {
    bf16* XB = (bf16*)(ws + WS_XB); bf16* HB = (bf16*)(ws + WS_H); bf16* ZB = (bf16*)(ws + WS_Z); bf16* MIXB = (bf16*)(ws + WS_MIX);
    float* SS0 = (float*)(ws + WS_SS0); float* SS1 = (float*)(ws + WS_SS1); float* SS2 = (float*)(ws + WS_SS2); float* SS3 = (float*)(ws + WS_SS3);
    (void)XB; (void)HB; (void)ZB; (void)MIXB; (void)SS0; (void)SS1; (void)SS2; (void)SS3;
        const int gw = F.vcu * NWAVES + F.wave, NGW = F.G * NWAVES;
        const GAS f32x4* lnf = (const GAS f32x4*)in.p[24] + F.lane;
        f32x4 gn[4];
#pragma unroll
        for (int j = 0; j < 4; ++j) gn[j] = lnf[64 * j];
        for (int m0 = gw; m0 < MROWS; m0 += 4 * NGW) {
            f32x4 v[4][4]; float rs[4];
#pragma unroll
            for (int r = 0; r < 4; ++r) {
                const int m = (m0 + r * NGW < MROWS) ? m0 + r * NGW : m0;
                rs[r] = pg8::row_rs16(SS3, m);
                const GAS f32x4* yr = (const GAS f32x4*)(outp + O_Y + (size_t)m * DM) + F.lane;
#pragma unroll
                for (int j = 0; j < 4; ++j) v[r][j] = yr[64 * j];
            }
#pragma unroll
            for (int r = 0; r < 4; ++r) {
                const int m = m0 + r * NGW;
                if (m < MROWS) {
                    GAS f32x4* yr = (GAS f32x4*)(outp + O_Y + (size_t)m * DM) + F.lane;
#pragma unroll
                    for (int j = 0; j < 4; ++j) yr[64 * j] = v[r][j] * rs[r] * gn[j];
                }
            }
        }
}
struct Args { In in; float* out; unsigned char* ws; int ph_lo, ph_hi; };
constexpr int N_PHASES = 10;
#ifndef DUP_PHASE
#define DUP_PHASE (-1)
#endif
__global__ void __launch_bounds__(NWAVES * 64, 2) mega_fwd(Args args) {
    extern __shared__ __attribute__((aligned(16))) unsigned char lds[];
    Frame F;
    F.lds = (LAS unsigned char*)lds;
    F.MISC = (volatile LAS unsigned*)(F.lds + MISC_OFF);
    F.tid = threadIdx.x; F.lane = F.tid & 63; F.wave = __builtin_amdgcn_readfirstlane(F.tid >> 6);
    F.G = gridDim.x; { const int bx = blockIdx.x; F.vcu = (F.G % 8 == 0) ? (bx % 8) * (F.G / 8) + bx / 8 : bx; }
    unsigned char* ws = args.ws; float* outp = args.out; const In& in = args.in;
    F.ctl = (gu32*)(ws + WS_CTL);
    for (int u = F.tid; u < (LDS_BYTES - LDSCTL_OFF) / 4; u += NWAVES * 64) ((LAS unsigned*)(F.lds + LDSCTL_OFF))[u] = 0u;
    __syncthreads();
    const int lo = args.ph_lo, hi = args.ph_hi;
    const bool use_bar = (hi - lo) > 1;
    XcdBarrier bar; bar.bar = (unsigned*)(F.ctl + CW_BAR); bar.x = 0; bar.st = nullptr;
    if (use_bar) bar = xcd_barrier_post((unsigned*)(F.ctl + CW_BAR), F.MISC + 8);
#define IN(k) (lo <= (k) && (k) < hi)
#define SEAM(k) do { if (IN(k) && IN((k) + 1)) xcd_barrier(bar); } while (0)
#define RUN(k) do { if (IN(k)) { phase_##k(F, in, ws, outp); if (DUP_PHASE == (k)) { xcd_barrier(bar); phase_##k(F, in, ws, outp); } } } while (0)
    RUN(0); SEAM(0);
    RUN(1); SEAM(1);
    RUN(2); SEAM(2);
    RUN(3); SEAM(3);
    RUN(4); SEAM(4);
    RUN(5); SEAM(5);
    RUN(6); SEAM(6);
    RUN(7); SEAM(7);
    RUN(8); SEAM(8);
    RUN(9);
#undef IN
#undef SEAM
#undef RUN
}

#ifndef MK_N_LAUNCHES
#define MK_N_LAUNCHES 1
#endif
extern "C" void kernel_launch(void* const* d_in, const int* in_sizes, int n_in, void* d_out, int out_size, void* d_ws, size_t ws_size, hipStream_t stream) {
    static int grid = 0;
    if (grid == 0) {
        if (n_in != 25 || in_sizes[0] != MP * DM || (size_t)out_size != O_END || ws_size < WS_END) { fprintf(stderr, "kernel_launch: unexpected shapes: n_in %d in0 %d out %d ws %zu\n", n_in, n_in > 0 ? in_sizes[0] : -1, out_size, ws_size); grid = -1; return; }
        int dev = 0, cus = 0, per_cu = 0;
        if (hipGetDevice(&dev) != hipSuccess || hipDeviceGetAttribute(&cus, hipDeviceAttributeMultiprocessorCount, dev) != hipSuccess) { grid = -1; return; }
        if (hipFuncSetAttribute((const void*)mega_fwd, hipFuncAttributeMaxDynamicSharedMemorySize, LDS_BYTES) != hipSuccess) { fprintf(stderr, "kernel_launch: hipFuncSetAttribute failed\n"); grid = -1; return; }
        if (hipOccupancyMaxActiveBlocksPerMultiprocessor(&per_cu, (const void*)mega_fwd, NWAVES * 64, LDS_BYTES) != hipSuccess || per_cu < 1) { fprintf(stderr, "kernel_launch: occupancy query says %d\n", per_cu); }
        (void)hipGetLastError();
        grid = cus;
    }
    if (grid < 0) return;
    if (hipMemsetAsync((char*)d_ws + WS_CTL, 0, CTL_ZERO_BYTES, stream) != hipSuccess) return;
    Args a{};
    for (int i = 0; i < 25; ++i) a.in.p[i] = (const float*)d_in[i];
    a.out = (float*)d_out; a.ws = (unsigned char*)d_ws;
#if MK_N_LAUNCHES == 1
    a.ph_lo = 0; a.ph_hi = N_PHASES;
    hipLaunchKernelGGL(mega_fwd, dim3(grid), dim3(NWAVES * 64), LDS_BYTES, stream, a);
#else
    for (int k = 0; k < N_PHASES; ++k) { a.ph_lo = k; a.ph_hi = k + 1; hipLaunchKernelGGL(mega_fwd, dim3(grid), dim3(NWAVES * 64), LDS_BYTES, stream, a); }
#endif
}
```

```cpp
#include <hip/hip_runtime.h>
#include <cstdio>
#include <cstdint>
namespace pg8 {
#define PG8_LAS __attribute__((address_space(3)))
typedef unsigned short bf16_t;
typedef short bf16x8 __attribute__((ext_vector_type(8)));
typedef float f32x4 __attribute__((ext_vector_type(4)));
typedef unsigned u32x4 __attribute__((ext_vector_type(4)));
constexpr int BM = 256, BK = 64, HALF = 128, HTB = HALF * BK * 2  , STAGE_BYTES = 8 * HTB, NXCD = 8, WGM = 8;

__host__ __device__ __forceinline__ int lds_byte(int r, int c) { const int st = (r >> 4) * 2 + (c >> 5), rr = r & 15, cc = c & 31, ob = rr * 64 + cc * 2; return st * 1024 + (ob ^ (((ob >> 9) & 1) << 5)); }
__host__ __device__ __forceinline__ void stage_rc(int b, int& R, int& C) { const int st = b / 1024, sb = b % 1024, swz = sb ^ (((sb >> 9) & 1) << 5); R = (st >> 1) * 16 + swz / 64; C = (st & 1) * 32 + (swz % 64) / 2; }
__host__ __device__ __forceinline__ int perm32(int rho) { const int n = rho >> 4, i = rho & 15; return 8 * (i >> 2) + 4 * n + (i & 3); }

struct Unit { int pm, pn; };
struct Gemm { const bf16_t* A; const bf16_t* Bt; int M, N, K; };

struct StaticOrder {
    int nM, nN, nwg, G, c, rev;
    __host__ __device__ void init(int M, int N, int G_, int c_) { nM = M / BM; nN = N / BM; nwg = nM * nN; G = G_; c = c_; rev = 0; }
    __host__ __device__ bool next(int i_, Unit& u) const {
        const int nc = (nwg - c + G - 1) / G;
        if (i_ >= nc) return false;
        const int i = rev ? nc - 1 - i_ : i_;
        const long L = (long)i * G + c; if (L >= nwg) return false;
        int wgid = (int)L; { const int q = nwg / NXCD, r = nwg % NXCD, xcd = wgid % NXCD, off = wgid / NXCD; wgid = (xcd < r ? xcd * (q + 1) : r * (q + 1) + (xcd - r) * q) + off; }
        const int nig = WGM * nN, gid = wgid / nig, fm = gid * WGM, gsz = (nM - fm) < WGM ? (nM - fm) : WGM;
        u.pm = fm + ((wgid % nig) % gsz); u.pn = (wgid % nig) / gsz; return true;
    }
    __device__ __forceinline__ void a_ready(const Unit&) const {}
    __device__ __forceinline__ void done(const Unit&) const {}
};
__device__ __forceinline__ unsigned cvt_pk_bf16(float lo, float hi) { unsigned r; asm volatile("v_cvt_pk_bf16_f32 %0, %1, %2" : "=v"(r) : "v"(lo), "v"(hi)); return r; }
typedef float f32x2 __attribute__((ext_vector_type(2)));
constexpr int E_DM = 1024, E_MP = 65536, E_MROWS = 66560;
constexpr size_t E_O_KWP = 68157440, E_O_VWP = 76546048, E_O_KNS = 84951040, E_O_VNS = 85475328;
constexpr float E_QSCALE = 0.125f * 1.4426950408889634f;
typedef unsigned u32x2 __attribute__((ext_vector_type(2)));
__device__ __forceinline__ float row_rs16(const float* ss, int row) {
    const f32x4* p = (const f32x4*)(ss + (size_t)row * 16);
    const f32x4 a = p[0], b = p[1], c = p[2], d = p[3];
    const float s = (((a[0] + a[1]) + (a[2] + a[3])) + ((b[0] + b[1]) + (b[2] + b[3]))) + (((c[0] + c[1]) + (c[2] + c[3])) + ((d[0] + d[1]) + (d[2] + d[3])));
    return __builtin_amdgcn_rsqf(s * (1.0f / 1024.0f) + 1e-6f);
}
__device__ __forceinline__ void rows_to_lds(PG8_LAS float* Rl, const f32x4& pf0, const f32x4& pf1) {
    float s = ((pf0[0] + pf0[1]) + (pf0[2] + pf0[3])) + ((pf1[0] + pf1[1]) + (pf1[2] + pf1[3]));
    s += __builtin_bit_cast(float, __builtin_amdgcn_update_dpp(0, __builtin_bit_cast(int, s), 0xB1, 0xF, 0xF, true));
    if ((threadIdx.x & 1) == 0) Rl[threadIdx.x >> 1] = __builtin_amdgcn_rsqf(s * (1.0f / 1024.0f) + 1e-6f);
    asm volatile("s_waitcnt lgkmcnt(0)\n\ts_barrier" ::: "memory");
}
template <bool RS> struct EpiSwiGLU {
    static constexpr bool PERM = true, AFTER_DRAIN = false, PREFETCH = RS;
    bf16_t* H; const float* ss; int ldh; PG8_LAS float* Rl;
    __device__ __forceinline__ void prefetch(const Unit& u, f32x4& pf0, f32x4& pf1) const {
        const f32x4* p = (const f32x4*)(ss + ((size_t)u.pm * BM + (threadIdx.x >> 1)) * 16 + (threadIdx.x & 1) * 8); pf0 = p[0]; pf1 = p[1];
    }
    __device__ __forceinline__ void operator()(const f32x4 (&acc)[2][2][4][2], const Unit& u, int wr, int wc, int fr, int fq, const f32x4& pf0, const f32x4& pf1) const {
        rows_to_lds(Rl, pf0, pf1);
        run(acc, u, wr, wc, fr, fq);
    }
    __device__ __forceinline__ void operator()(const f32x4 (&acc)[2][2][4][2], const Unit& u, int wr, int wc, int fr, int fq) const { run(acc, u, wr, wc, fr, fq); }
    __device__ __forceinline__ void run(const f32x4 (&acc)[2][2][4][2], const Unit& u, int wr, int wc, int fr, int fq) const {
        typedef float f32x2 __attribute__((ext_vector_type(2)));
        const int row0 = u.pm * BM + wr * 64 + fr, col0 = u.pn * HALF + wc * 32 + 8 * fq;
#pragma unroll
        for (int ai = 0; ai < 2; ++ai) {
            float rs[4];
#pragma unroll
            for (int m = 0; m < 4; ++m) rs[m] = RS ? Rl[ai * HALF + wr * 64 + m * 16 + fr] : 1.0f;
#pragma unroll
            for (int m = 0; m < 4; ++m) {
                const int row = row0 + ai * HALF + m * 16;
                f32x2 hv[4];
#pragma unroll
                for (int n = 0; n < 2; ++n)
#pragma unroll
                    for (int e = 0; e < 2; ++e) {
                        f32x2 t = (f32x2){acc[ai][0][m][n][2 * e], acc[ai][0][m][n][2 * e + 1]};
                        f32x2 p = (f32x2){acc[ai][1][m][n][2 * e], acc[ai][1][m][n][2 * e + 1]};
                        if (RS) { t = t * rs[m]; p = p * rs[m]; }
                        p = p * t;
                        f32x2 d; d.x = __builtin_amdgcn_exp2f(t.x); d.y = __builtin_amdgcn_exp2f(t.y);
                        d = d + 1.0f;
                        f32x2 r; r.x = __builtin_amdgcn_rcpf(d.x); r.y = __builtin_amdgcn_rcpf(d.y);
                        hv[n * 2 + e] = p * r;
                    }
                u32x4 w; w.x = cvt_pk_bf16(hv[0].x, hv[0].y); w.y = cvt_pk_bf16(hv[1].x, hv[1].y); w.z = cvt_pk_bf16(hv[2].x, hv[2].y); w.w = cvt_pk_bf16(hv[3].x, hv[3].y);
                *(u32x4*)(H + (size_t)row * ldh + col0) = w;
            }
        }
    }
};
template <bool BB, bool OF, bool OB, bool PT> struct EpiResid {
    static constexpr bool PERM = true, AFTER_DRAIN = false, PREFETCH = false;
    const float* base; const float* ri; float* outf; bf16_t* xb; float* ss; PG8_LAS float* T; float alpha;
    __device__ __forceinline__ void operator()(const f32x4 (&acc)[2][2][4][2], const Unit& u, int wr, int wc, int fr_, int fq_) const {
        int fr = fr_, fq = fq_; asm volatile("" : "+v"(fr), "+v"(fq));
        const int row0 = u.pm * BM + wr * 64 + fr, col0 = u.pn * BM + wc * 32 + 8 * fq;
#pragma unroll
        for (int ai = 0; ai < 2; ++ai) {
            u32x4 praw[BB ? 4 : 1][2]; f32x4 pre[BB ? 1 : 4][2][2]; float rinv[4];
#pragma unroll
            for (int m = 0; m < 4; ++m) {
                rinv[m] = (BB && ri) ? ri[row0 + ai * HALF + m * 16] : 1.0f;
#pragma unroll
                for (int bj = 0; bj < 2; ++bj) {
                    const size_t off = (size_t)(row0 + ai * HALF + m * 16) * E_DM + col0 + bj * HALF;
                    if (BB) praw[m][bj] = *(const u32x4*)(xb + off);
                    else { pre[m][bj][0] = *(const f32x4*)(base + off); pre[m][bj][1] = *(const f32x4*)(base + off + 4); }
                }
            }
            if (BB) asm volatile("" ::: "memory");
#pragma unroll
            for (int m = 0; m < 4; ++m) {
                const int row = row0 + ai * HALF + m * 16; float q = 0.f;
#pragma unroll
                for (int bj = 0; bj < 2; ++bj) {
                    const size_t off = (size_t)row * E_DM + col0 + bj * HALF;
                    f32x4 b0, b1;
                    if (BB) { const u32x4 w = praw[BB ? m : 0][bj];
                        b0 = (f32x4){__builtin_bit_cast(float, w.x << 16), __builtin_bit_cast(float, w.x & 0xffff0000u), __builtin_bit_cast(float, w.y << 16), __builtin_bit_cast(float, w.y & 0xffff0000u)} * rinv[m];
                        b1 = (f32x4){__builtin_bit_cast(float, w.z << 16), __builtin_bit_cast(float, w.z & 0xffff0000u), __builtin_bit_cast(float, w.w << 16), __builtin_bit_cast(float, w.w & 0xffff0000u)} * rinv[m]; }
                    else { b0 = pre[BB ? 0 : m][bj][0]; b1 = pre[BB ? 0 : m][bj][1]; }
                    const f32x4 o0 = b0 + acc[ai][bj][m][0] * alpha, o1 = b1 + acc[ai][bj][m][1] * alpha;
                    if (OF) { *(f32x4*)(outf + off) = o0; *(f32x4*)(outf + off + 4) = o1; }
                    q += ((o0[0] * o0[0] + o0[1] * o0[1]) + (o0[2] * o0[2] + o0[3] * o0[3])) + ((o1[0] * o1[0] + o1[1] * o1[1]) + (o1[2] * o1[2] + o1[3] * o1[3]));
                    if (OB) { u32x4 w; w.x = cvt_pk_bf16(o0[0], o0[1]); w.y = cvt_pk_bf16(o0[2], o0[3]); w.z = cvt_pk_bf16(o1[0], o1[1]); w.w = cvt_pk_bf16(o1[2], o1[3]); *(u32x4*)(xb + off) = w; }
                }
                q += __shfl_xor(q, 16); q += __shfl_xor(q, 32);
                if (fq == 0) ss[(size_t)row * 16 + u.pn * 4 + wc] = q;
            }
        }
    }
};
struct EpiZ {
    static constexpr bool PERM = true, AFTER_DRAIN = false, PREFETCH = true;
    bf16_t* Z; const float* ss; float* outp; PG8_LAS float* Rl;
    __device__ __forceinline__ void prefetch(const Unit& u, f32x4& pf0, f32x4& pf1) const {
        const f32x4* p = (const f32x4*)(ss + ((size_t)u.pm * BM + (threadIdx.x >> 1)) * 16 + (threadIdx.x & 1) * 8); pf0 = p[0]; pf1 = p[1];
    }
    __device__ __forceinline__ void operator()(const f32x4 (&acc)[2][2][4][2], const Unit& u, int wr, int wc, int fr, int fq, const f32x4& pf0, const f32x4& pf1) const {
        rows_to_lds(Rl, pf0, pf1);
        const int t = u.pn >> 1, colt = (u.pn & 1) * BM;
        bf16_t* zb = Z + (size_t)t * ((size_t)E_MROWS * 512);
        const float sc = (t == 0) ? E_QSCALE : 1.0f;
        const int row0 = u.pm * BM + wr * 64 + fr, col0 = colt + wc * 32 + 8 * fq;
        const bool wout = (t == 1 || t == 2) && (u.pm >= 256 || (u.pm & 31) >= 24);
#pragma unroll
        for (int ai = 0; ai < 2; ++ai) {
            float rs[4];
#pragma unroll
            for (int m = 0; m < 4; ++m) rs[m] = Rl[ai * HALF + wr * 64 + m * 16 + fr] * sc;
#pragma unroll
            for (int m = 0; m < 4; ++m) {
                const int row = row0 + ai * HALF + m * 16;
                size_t oo = 0;
                if (wout) { if (row < E_MP) oo = (t == 1 ? E_O_KWP : E_O_VWP) + ((size_t)((row >> 13) * 2048 + (row & 8191) - 6144)) * 512; else oo = (t == 1 ? E_O_KNS : E_O_VNS) + (size_t)(row - E_MP) * 512; }
#pragma unroll
                for (int bj = 0; bj < 2; ++bj) {
                    const f32x4 v0 = acc[ai][bj][m][0] * rs[m], v1 = acc[ai][bj][m][1] * rs[m];
                    u32x4 w; w.x = cvt_pk_bf16(v0[0], v0[1]); w.y = cvt_pk_bf16(v0[2], v0[3]); w.z = cvt_pk_bf16(v1[0], v1[1]); w.w = cvt_pk_bf16(v1[2], v1[3]);
                    if (t == 1 || t == 2) {
                        if (row < E_MP) { const int cc = col0 + bj * HALF; *(u32x4*)(zb + ((((size_t)(row >> 13) * 8 + (cc >> 6)) * 16 + (row & 15)) * 512 + ((row & 8191) >> 4)) * 64 + (cc & 63)) = w; }
                    } else *(u32x4*)(zb + (size_t)row * 512 + col0 + bj * HALF) = w;
                    if (wout) { float* op = outp + oo + col0 + bj * HALF; *(f32x4*)op = v0; *(f32x4*)(op + 4) = v1; }
                }
            }
        }
    }
};

template <class Epi, class Sched, bool ALIGN_EPI = false, bool SP2 = false>
__device__ __forceinline__ void gemm_phase(PG8_LAS unsigned char* lds, const Gemm g, const Sched& S, const Epi& E) {
    const int tid = threadIdx.x, wid = __builtin_amdgcn_readfirstlane(tid >> 6), lane = tid & 63, wr = wid >> 2, wc = wid & 3, fr = lane & 15, fq = lane >> 4;
    const int K = g.K, nt = K / BK;
    unsigned voffA[2], voffB[2];
#pragma unroll
    for (int i = 0; i < 2; ++i) { int R, C; stage_rc(tid * 16 + i * 8192, R, C); const int Rb = Epi::PERM ? ((R & ~31) + perm32(R & 31)) : R;
        voffA[i] = (unsigned)(R * K + C) * 2u; voffB[i] = (unsigned)(Rb * K + C) * 2u; }
    const size_t kstep = (size_t)(BK * 2);
    const size_t hstep = (size_t)HALF * K * 2;
    const size_t tstep = 2 * hstep;
    const unsigned ldsw = (unsigned)wid * 1024u;
    const int aoff = lds_byte(wr * 64 + fr, fq * 8), boff = lds_byte(wc * 32 + fr, fq * 8);
#define PG8_SA(b, h) (((b) * 2 + (h)) * HTB)
#define PG8_SB(b, h) ((4 + (b) * 2 + (h)) * HTB)
#define PG8_STAGE(bufoff, gbase, voff) do { _Pragma("unroll") for (int _i = 0; _i < 2; ++_i) \
        __builtin_amdgcn_global_load_lds((const unsigned*)((const char*)(gbase) + (voff)[_i]), (PG8_LAS unsigned*)(lds + (bufoff) + ldsw + _i * 8192), 16, 0, 0); } while (0)
#define PG8_LDA(dst, b, h) do { _Pragma("unroll") for (int m = 0; m < 4; ++m) _Pragma("unroll") for (int k = 0; k < 2; ++k) dst[m][k] = *(const PG8_LAS bf16x8*)(lds + PG8_SA(b, h) + aoff + m * 2048 + k * 1024); } while (0)
#define PG8_LDB(dst, b, h) do { _Pragma("unroll") for (int n = 0; n < 2; ++n) _Pragma("unroll") for (int k = 0; k < 2; ++k) dst[n][k] = *(const PG8_LAS bf16x8*)(lds + PG8_SB(b, h) + boff + n * 2048 + k * 1024); } while (0)
#define PG8_MMA(ai, bj, At, Bt) do { __builtin_amdgcn_s_setprio(1); _Pragma("unroll") for (int m = 0; m < 4; ++m) _Pragma("unroll") for (int n = 0; n < 2; ++n) _Pragma("unroll") for (int k = 0; k < 2; ++k) \
        acc[ai][bj][m][n] = __builtin_amdgcn_mfma_f32_16x16x32_bf16(Bt[n][k], At[m][k], acc[ai][bj][m][n], 0, 0, 0); __builtin_amdgcn_s_setprio(0); } while (0)
#define PG8_WAIT_V(n) asm volatile("s_waitcnt vmcnt(" #n ")" ::: "memory")
#define PG8_WAIT_L(n) asm volatile("s_waitcnt lgkmcnt(" #n ")" ::: "memory")
#define PG8_BAR __builtin_amdgcn_s_barrier()
#define PG8_SCHED __builtin_amdgcn_sched_barrier(0)
    Unit cur, nxt; int ui = 0;
    if (!S.next(0, cur)) return;
    f32x4 acc[2][2][4][2];
    f32x4 pf0 = (f32x4){0.f, 0.f, 0.f, 0.f}, pf1 = pf0;
#pragma unroll
    for (int a = 0; a < 2; ++a)
#pragma unroll
        for (int b = 0; b < 2; ++b)
#pragma unroll
            for (int m = 0; m < 4; ++m)
#pragma unroll
                for (int n = 0; n < 2; ++n) acc[a][b][m][n] = (f32x4){0.f, 0.f, 0.f, 0.f};
    bf16x8 At[4][2], B0[2][2], B1[2][2];
    const char* cA = (const char*)g.A + (size_t)cur.pm * tstep; const char* cB = (const char*)g.Bt + (size_t)cur.pn * tstep;
    S.a_ready(cur);
    if constexpr (SP2) {
        PG8_STAGE(PG8_SB(0, 0), cB, voffB); PG8_STAGE(PG8_SB(0, 1), cB + hstep, voffB); PG8_STAGE(PG8_SA(0, 0), cA, voffA); PG8_STAGE(PG8_SA(0, 1), cA + hstep, voffA);
        if (wr == 1) PG8_BAR;
        PG8_WAIT_V(2); PG8_BAR;
        PG8_STAGE(PG8_SB(1, 0), cB + kstep, voffB); PG8_STAGE(PG8_SA(1, 0), cA + kstep, voffA); PG8_STAGE(PG8_SB(1, 1), cB + hstep + kstep, voffB);
        PG8_WAIT_V(6); PG8_BAR;
    } else {
        PG8_STAGE(PG8_SB(0, 0), cB, voffB); PG8_STAGE(PG8_SA(0, 0), cA, voffA); PG8_STAGE(PG8_SB(0, 1), cB + hstep, voffB); PG8_STAGE(PG8_SA(0, 1), cA + hstep, voffA);
        if (wr == 1) PG8_BAR;
        PG8_WAIT_V(4); PG8_BAR;
        PG8_STAGE(PG8_SB(1, 0), cB + kstep, voffB); PG8_STAGE(PG8_SA(1, 0), cA + kstep, voffA); PG8_STAGE(PG8_SB(1, 1), cB + hstep + kstep, voffB);
        PG8_WAIT_V(6); PG8_BAR;
    }
    for (;;) {
        const bool has_next = S.next(ui + 1, nxt);
        const char* nA = has_next ? (const char*)g.A + (size_t)nxt.pm * tstep : cA; const char* nB = has_next ? (const char*)g.Bt + (size_t)nxt.pn * tstep : cB;
        for (int t = 0; t < nt; t += 2) {
            const bool last = (t == nt - 2);
            const char* a1 = cA + (size_t)(t + 1) * kstep;
            const char* a2 = last ? nA : cA + (size_t)(t + 2) * kstep; const char* b2 = last ? nB : cB + (size_t)(t + 2) * kstep;
            const char* a3 = a2 + kstep; const char* b3 = b2 + kstep;
            if (last && has_next) S.a_ready(nxt);
            if constexpr (Epi::PREFETCH) { if (last) E.prefetch(cur, pf0, pf1); }
            if constexpr (SP2) {
            PG8_LDB(B0, 0, 0); PG8_LDB(B1, 0, 1); PG8_SCHED; PG8_LDA(At, 0, 0); PG8_STAGE(PG8_SA(1, 1), a1 + hstep, voffA);
            PG8_WAIT_V(8); PG8_WAIT_L(0); PG8_BAR; PG8_MMA(0, 0, At, B0); PG8_MMA(0, 1, At, B1); PG8_BAR; PG8_SCHED;
            PG8_LDA(At, 0, 1); PG8_STAGE(PG8_SB(0, 0), b2, voffB); PG8_STAGE(PG8_SB(0, 1), b2 + hstep, voffB); PG8_STAGE(PG8_SA(0, 0), a2, voffA);
            PG8_WAIT_V(8); PG8_WAIT_L(0); PG8_BAR; PG8_MMA(1, 0, At, B0); PG8_MMA(1, 1, At, B1); PG8_BAR; PG8_SCHED;
            PG8_LDB(B0, 1, 0); PG8_LDB(B1, 1, 1); PG8_SCHED; PG8_LDA(At, 1, 0); PG8_STAGE(PG8_SA(0, 1), a2 + hstep, voffA);
            PG8_WAIT_V(8); PG8_WAIT_L(0); PG8_BAR; PG8_MMA(0, 0, At, B0); PG8_MMA(0, 1, At, B1); PG8_BAR; PG8_SCHED;
            PG8_LDA(At, 1, 1); PG8_STAGE(PG8_SB(1, 0), b3, voffB); PG8_STAGE(PG8_SB(1, 1), b3 + hstep, voffB); PG8_STAGE(PG8_SA(1, 0), a3, voffA);
            PG8_WAIT_V(8); PG8_WAIT_L(0); PG8_BAR; PG8_MMA(1, 0, At, B0); PG8_MMA(1, 1, At, B1); PG8_BAR; PG8_SCHED;
            } else {
            PG8_LDB(B0, 0, 0); PG8_SCHED; PG8_LDA(At, 0, 0); PG8_STAGE(PG8_SA(1, 1), a1 + hstep, voffA);
            PG8_WAIT_L(8); PG8_BAR; PG8_WAIT_L(0); PG8_MMA(0, 0, At, B0); PG8_BAR; PG8_SCHED;
            PG8_LDB(B1, 0, 1); PG8_STAGE(PG8_SB(0, 0), b2, voffB);
            PG8_BAR; PG8_WAIT_L(0); PG8_MMA(0, 1, At, B1); PG8_BAR;
            PG8_LDA(At, 0, 1); PG8_STAGE(PG8_SA(0, 0), a2, voffA);
            PG8_BAR; PG8_WAIT_L(0); PG8_MMA(1, 0, At, B0); PG8_BAR; PG8_SCHED;
            PG8_STAGE(PG8_SB(0, 1), b2 + hstep, voffB);
            PG8_WAIT_V(6); PG8_BAR; PG8_MMA(1, 1, At, B1); PG8_BAR;
            PG8_LDB(B0, 1, 0); PG8_SCHED; PG8_LDA(At, 1, 0); PG8_STAGE(PG8_SA(0, 1), a2 + hstep, voffA);
            PG8_WAIT_L(8); PG8_BAR; PG8_WAIT_L(0); PG8_MMA(0, 0, At, B0); PG8_BAR; PG8_SCHED;
            PG8_LDB(B1, 1, 1); PG8_STAGE(PG8_SB(1, 0), b3, voffB);
            PG8_BAR; PG8_WAIT_L(0); PG8_MMA(0, 1, At, B1); PG8_BAR;
            PG8_LDA(At, 1, 1); PG8_STAGE(PG8_SA(1, 0), a3, voffA);
            PG8_BAR; PG8_WAIT_L(0); PG8_MMA(1, 0, At, B0); PG8_BAR; PG8_SCHED;
            PG8_STAGE(PG8_SB(1, 1), b3 + hstep, voffB);
            PG8_WAIT_V(6); PG8_BAR; PG8_MMA(1, 1, At, B1); PG8_BAR;
            }
        }
        if constexpr (ALIGN_EPI) { if (wr == 0) PG8_BAR; }
        if constexpr (!Epi::AFTER_DRAIN) { if constexpr (Epi::PREFETCH) E(acc, cur, wr, wc, fr, fq, pf0, pf1); else E(acc, cur, wr, wc, fr, fq); S.done(cur); }
        if (!has_next) break;
#pragma unroll
        for (int a = 0; a < 2; ++a)
#pragma unroll
            for (int b = 0; b < 2; ++b)
#pragma unroll
                for (int m = 0; m < 4; ++m)
#pragma unroll
                    for (int n = 0; n < 2; ++n) acc[a][b][m][n] = (f32x4){0.f, 0.f, 0.f, 0.f};
        cur = nxt; cA = nA; cB = nB; ++ui;
        if constexpr (ALIGN_EPI) { if (wr == 1) PG8_BAR; }
    }
    PG8_WAIT_V(0);
    if constexpr (!ALIGN_EPI) { if (wr == 0) PG8_BAR; }
    PG8_BAR;
    if constexpr (Epi::AFTER_DRAIN) { E.fused(acc, cur, wr, wc, fr, fq, lds, wid, lane); S.done(cur); }
#undef PG8_SA
#undef PG8_SB
#undef PG8_STAGE
#undef PG8_LDA
#undef PG8_LDB
#undef PG8_MMA
#undef PG8_WAIT_V
#undef PG8_WAIT_L
#undef PG8_BAR
#undef PG8_SCHED
}
}
#define GAS __attribute__((address_space(1)))
#define LAS __attribute__((address_space(3)))
typedef unsigned short bf16;
typedef unsigned v4u __attribute__((ext_vector_type(4)));
typedef float f32x4 __attribute__((ext_vector_type(4)));
typedef short bf16x8 __attribute__((ext_vector_type(8)));
typedef GAS unsigned gu32;
typedef GAS unsigned long long gu64;
#define RLX_AGENT __ATOMIC_RELAXED, __HIP_MEMORY_SCOPE_AGENT
#define LDS_WAIT() asm volatile("s_waitcnt lgkmcnt(0)" ::: "memory")
#define VM_WAIT() asm volatile("s_waitcnt vmcnt(0)" ::: "memory")
__device__ __forceinline__ unsigned long long rt() { return __builtin_amdgcn_s_memrealtime(); }
__device__ __forceinline__ unsigned f2bf(float f) { unsigned u = __builtin_bit_cast(unsigned, f); return (u + 0x7fffu + ((u >> 16) & 1u)) >> 16; }
__device__ __forceinline__ unsigned pk2(float lo, float hi) { return f2bf(lo) | (f2bf(hi) << 16); }

#define XB_TMO      128
#define XB_XCNT(j)  (256  + 64 * (j))
#define XB_XSUB(j)  (1280 + 64 * (j))
#define XB_XGEN(j)  (2304 + 64 * (j))
#define XB_TOP      3328
#define XB_TOPGEN   3392
#define XCD_BAR_WORDS 3456
#define XB_SPIN_CAP (1u << 18)

__device__ __forceinline__ unsigned xb_ld(unsigned* p)              { return __hip_atomic_load(p, __ATOMIC_RELAXED, __HIP_MEMORY_SCOPE_AGENT); }
__device__ __forceinline__ unsigned xb_add(unsigned* p, unsigned v) { return __hip_atomic_fetch_add(p, v, __ATOMIC_RELAXED, __HIP_MEMORY_SCOPE_AGENT); }
__device__ __forceinline__ unsigned xb_xcc_id() { return (unsigned)__builtin_amdgcn_s_getreg((3 << 11) | 20) & 0xFu; }
#define XB_SPIN(cond, bar) do { unsigned _sp = 0; while (cond) { __builtin_amdgcn_s_sleep(1); \
    if ((++_sp & 255u) == 0u) { if (xb_ld(&(bar)[XB_TMO])) break; if (_sp > XB_SPIN_CAP) { atomicAdd(&(bar)[XB_TMO], 1u); break; } } } } while (0)

struct XcdBarrier {
    unsigned* bar; unsigned x;
    volatile LAS unsigned* st;
};

__device__ __forceinline__ XcdBarrier xcd_barrier_post(unsigned* bar, volatile LAS unsigned* st) {
    XcdBarrier b; b.bar = bar; b.x = xb_xcc_id(); b.st = st;
    if (threadIdx.x == 0) (void)xb_add(&bar[XB_XCNT(b.x)], 1u);
    return b;
}
__device__ __forceinline__ void xcd_barrier_complete(unsigned* bar, unsigned x, unsigned& nloc, unsigned& nx) {
    const unsigned G = gridDim.x * gridDim.y * gridDim.z;
    unsigned sum, cnt, mine, sp = 0u;
    for (;;) {
        sum = 0u; cnt = 0u; mine = 0u;
#pragma unroll
        for (unsigned j = 0; j < 16; ++j) { const unsigned c = xb_ld(&bar[XB_XCNT(j)]); sum += c; cnt += (c > 0u) ? 1u : 0u; mine = (j == x) ? c : mine; }
        if (sum == G) break;
        __builtin_amdgcn_s_sleep(1);
        if ((++sp & 255u) == 0u) { if (xb_ld(&bar[XB_TMO])) break; if (sp > XB_SPIN_CAP) { atomicAdd(&bar[XB_TMO], 1u); break; } }
    }
    nloc = mine > 0u ? mine : 1u; nx = cnt > 0u ? cnt : 1u;
}

__device__ __forceinline__ void xcd_barrier(const XcdBarrier& b) {
    asm volatile("s_waitcnt vmcnt(0)" ::: "memory");
    __syncthreads();
    if (threadIdx.x == 0) {
        unsigned* bar = b.bar;
        __builtin_amdgcn_s_waitcnt(0);
        unsigned nloc = b.st[0], nx = b.st[1];
        if (nloc == 0u) { xcd_barrier_complete(bar, b.x, nloc, nx); b.st[0] = nloc; b.st[1] = nx; }
        const unsigned old = xb_add(&bar[XB_XSUB(b.x)], 1u);
        const unsigned gen = old / nloc;
        if (old + 1u == (gen + 1u) * nloc) {
            __builtin_amdgcn_fence(__ATOMIC_RELEASE, "agent");
            asm volatile("s_waitcnt vmcnt(0)" ::: "memory");
            const unsigned og = xb_add(&bar[XB_TOP], 1u);
            const unsigned tg = og / nx;
            if (og + 1u == (tg + 1u) * nx) xb_add(&bar[XB_TOPGEN], 1u);
            else XB_SPIN(xb_ld(&bar[XB_TOPGEN]) == tg, bar);
            __builtin_amdgcn_fence(__ATOMIC_ACQUIRE, "agent");
            xb_add(&bar[XB_XGEN(b.x)], 1u);
            asm volatile("s_waitcnt vmcnt(0)" ::: "memory");
        } else {
            XB_SPIN(xb_ld(&bar[XB_XGEN(b.x)]) == gen, bar);
            __builtin_amdgcn_fence(__ATOMIC_ACQUIRE, "agent");
            asm volatile("s_waitcnt vmcnt(0)" ::: "memory");
        }
    }
    __syncthreads();
}

constexpr int NWAVES = 8;
constexpr int DM = 1024, DFF = 2816, NHEAD = 8, HD = 64, DATT = 512, DRNN = 512;
constexpr int BATCH = 8, SEQ = 8192, DECB = 128, DECT = 8, WBUF = 2048;
constexpr int MP = BATCH * SEQ, MS = DECB * DECT, MROWS = MP + MS;
constexpr int NGU = 2 * DFF, NIN = 3 * DATT + 2 * DRNN;
constexpr int NCHUNK = SEQ / 256;
static_assert(MROWS % 256 == 0 && MROWS == pg8::E_MROWS && MP == pg8::E_MP && DM == pg8::E_DM, "shapes");
constexpr size_t O_Y = 0, O_KWP = 68157440, O_VWP = 76546048, O_LHP = 84934656, O_LCP = 84938752, O_KNS = 84951040, O_VNS = 85475328, O_LHS = 85999616, O_LCS = 86065152, O_END = 86261760;
static_assert(O_KWP == pg8::E_O_KWP && O_VWP == pg8::E_O_VWP && O_KNS == pg8::E_O_KNS && O_VNS == pg8::E_O_VNS, "offsets");
constexpr size_t MiB = 1u << 20;
constexpr size_t WS_CTL = 0, CTL_ZERO_BYTES = 1 * MiB;
constexpr size_t WS_W1GU = 2 * MiB, WS_W1D = 13 * MiB, WS_WIN = 19 * MiB, WS_WOUT = 24 * MiB, WS_W2GU = 26 * MiB, WS_W2D = 37 * MiB, WS_WGA = 43 * MiB, WS_WGX = 43 * MiB + 65536;
constexpr size_t WS_SS0 = 44 * MiB  , WS_SS1 = 49 * MiB, WS_SS2 = 54 * MiB, WS_SS3 = 59 * MiB;
constexpr size_t WS_RSA = 64 * MiB, WS_RSB = 64 * MiB + 524288;
constexpr size_t WS_RI0 = 65 * MiB;
constexpr size_t WS_PL = 66 * MiB;
constexpr size_t WS_XB = 128 * MiB;
constexpr size_t WS_H = 258 * MiB;
constexpr size_t WS_PO = 258 * MiB;
constexpr size_t WS_Z = 616 * MiB;
constexpr size_t WS_MIX = 941 * MiB;
constexpr size_t WS_END = 1072 * MiB;
constexpr int CW_BAR = 4096;
constexpr int RING_OFF = 0, RING_BYTES = 131072;
constexpr int QBUF_OFF = RING_BYTES, QBUF_BYTES = 16384;
constexpr int WARM_OFF = QBUF_OFF + QBUF_BYTES, WARM_BYTES = 2048;
constexpr int LDSCTL_OFF = WARM_OFF + WARM_BYTES, MISC_OFF = LDSCTL_OFF + 320;
constexpr int LDS_BYTES = 150528;

struct Frame {
    LAS unsigned char* lds;
    volatile LAS unsigned* MISC;
    gu32* ctl;
    int tid, lane, wave;
    int vcu, G;
};

__device__ __forceinline__ float wave_sum(float v) {
#pragma unroll
    for (int o = 1; o < 64; o <<= 1) v += __shfl_xor(v, o);
    return v;
}
__device__ __forceinline__ float bf2f(unsigned short b) { return __builtin_bit_cast(float, (unsigned)b << 16); }
__device__ __forceinline__ float fsigmoid(float x) { return __builtin_amdgcn_rcpf(1.0f + __builtin_amdgcn_exp2f(-1.4426950408889634f * x)); }

template <int CTRL> __device__ __forceinline__ float dppmov(float v) { return __builtin_bit_cast(float, __builtin_amdgcn_update_dpp(0, __builtin_bit_cast(int, v), CTRL, 0xF, 0xF, true)); }
__device__ __forceinline__ float sum16(float v) {
    v += dppmov<0xB1>(v); v += dppmov<0x4E>(v); v += dppmov<0x141>(v); v += dppmov<0x140>(v); return v;
}
__device__ __forceinline__ float rows_max(float v) {
    { auto rr = __builtin_amdgcn_permlane16_swap(__float_as_uint(v), __float_as_uint(v), false, false); v = fmaxf(__uint_as_float(rr[0]), __uint_as_float(rr[1])); }
    { auto rr = __builtin_amdgcn_permlane32_swap(__float_as_uint(v), __float_as_uint(v), false, false); v = fmaxf(__uint_as_float(rr[0]), __uint_as_float(rr[1])); }
    return v;
}
__device__ __forceinline__ float rows_sum(float v) {
    { auto rr = __builtin_amdgcn_permlane16_swap(__float_as_uint(v), __float_as_uint(v), false, false); v = __uint_as_float(rr[0]) + __uint_as_float(rr[1]); }
    { auto rr = __builtin_amdgcn_permlane32_swap(__float_as_uint(v), __float_as_uint(v), false, false); v = __uint_as_float(rr[0]) + __uint_as_float(rr[1]); }
    return v;
}

__device__ __forceinline__ void p0_transpose_item(const float* W, int ldw, const float* ksc, int k0, int n0, bf16* WT, int K, int dst_row0, LAS float* scr, int lane, float kmul = 1.0f) {
    float wv[32], wsc[32];
#pragma unroll
    for (int i = 0; i < 32; ++i) { const int kk = 2 * i + (lane >> 5); wv[i] = W[(size_t)(k0 + kk) * ldw + n0 + (lane & 31)]; wsc[i] = ksc ? ksc[k0 + kk] * kmul : kmul; }
#pragma unroll
    for (int i = 0; i < 32; ++i) { const int kk = 2 * i + (lane >> 5); scr[kk * 33 + (lane & 31)] = wv[i] * wsc[i]; }
    LDS_WAIT(); asm volatile("" ::: "memory");
    const int c = lane & 7;
#pragma unroll
    for (int j = 0; j < 4; ++j) { const int n = (lane >> 3) + 8 * j; const LAS float* s = scr + (8 * c) * 33 + n;
        v4u o; o.x = pk2(s[0 * 33], s[1 * 33]); o.y = pk2(s[2 * 33], s[3 * 33]); o.z = pk2(s[4 * 33], s[5 * 33]); o.w = pk2(s[6 * 33], s[7 * 33]);
        *(GAS v4u*)(WT + (size_t)(dst_row0 + n) * K + k0 + 8 * c) = o; }
    LDS_WAIT(); asm volatile("" ::: "memory");
}
struct In { const float* p[25]; };
__device__ __forceinline__ void p0_prologue(Frame& F, const In& in, unsigned char* ws) {
    LAS float* scr = (LAS float*)(F.lds + RING_OFF + F.wave * 16384);
    const int gw = F.vcu * NWAVES + F.wave, NGW = F.G * NWAVES;
    constexpr int I_GU = (DM / 64) * (DFF / 32), I_D = (DFF / 64) * (DM / 32), I_IN = (DM / 64) * (NIN / 32), I_O = (DM / 64) * (DM / 32);
    constexpr int NITEMS = 4 * I_GU + 2 * I_D + I_IN + I_O;
    for (int it = gw; it < NITEMS; it += NGW) {
        int r = it;
        if (r < 4 * I_GU) {
            const int which = r / I_GU; r -= which * I_GU;
            const int nb = r % (DFF / 32), kb = r / (DFF / 32), n0 = 32 * nb;
            const float* W = in.p[which == 0 ? 7 : which == 1 ? 8 : which == 2 ? 21 : 22];
            const float* ln = in.p[which < 2 ? 6 : 20];
            bf16* WT = (bf16*)(ws + (which < 2 ? WS_W1GU : WS_W2GU));
            p0_transpose_item(W, DFF, ln, 64 * kb, n0, WT, DM, (n0 / 128) * 256 + (n0 % 128) + ((which & 1) ? 128 : 0), scr, F.lane, (which & 1) ? -0.6931471805599453f : -1.4426950408889634f);
            continue;
        }
        r -= 4 * I_GU;
        if (r < 2 * I_D) {
            const int which = r / I_D; r -= which * I_D;
            const int nb = r % (DM / 32), kb = r / (DM / 32);
            p0_transpose_item(in.p[which == 0 ? 9 : 23], DM, nullptr, 64 * kb, 32 * nb, (bf16*)(ws + (which == 0 ? WS_W1D : WS_W2D)), DFF, 32 * nb, scr, F.lane);
            continue;
        }
        r -= 2 * I_D;
        if (r < I_IN) { const int nb = r % (NIN / 32), kb = r / (NIN / 32); p0_transpose_item(in.p[11], NIN, in.p[10], 64 * kb, 32 * nb, (bf16*)(ws + WS_WIN), DM, 32 * nb, scr, F.lane); continue; }
        r -= I_IN;
        { const int nb = r % (DM / 32), kb = r / (DM / 32); p0_transpose_item(in.p[19], DM, nullptr, 64 * kb, 32 * nb, (bf16*)(ws + WS_WOUT), DM, 32 * nb, scr, F.lane); }
    }
    for (int e = (F.vcu * NWAVES + F.wave) * 64 + F.lane; e < 2 * 32768; e += NGW * 64) {
        const int which = e >> 15, r = e & 32767, n = r >> 12, d = (r >> 6) & 63, c = r & 63;
        const float v = in.p[which ? 16 : 14][(n * 64 + c) * 64 + d];
        ((bf16*)(ws + (which ? WS_WGX : WS_WGA)))[r] = (bf16)f2bf(v * -1.4426950408889634f);
    }
    bf16* XB = (bf16*)(ws + WS_XB); float* RI0 = (float*)(ws + WS_RI0);
    for (int m0 = gw; m0 < MROWS; m0 += 8 * NGW) {
        f32x4 v[8][4];
#pragma unroll
        for (int r = 0; r < 8; ++r) {
            const int m = (m0 + r * NGW < MROWS) ? m0 + r * NGW : m0;
            const float* xrow = (m < MP) ? in.p[0] + (size_t)m * DM : in.p[1] + (size_t)(m - MP) * DM;
            const GAS f32x4* xr = (const GAS f32x4*)xrow + F.lane;
#pragma unroll
            for (int j = 0; j < 4; ++j) v[r][j] = xr[64 * j];
        }
#pragma unroll
        for (int r = 0; r < 8; ++r) {
            const int m = m0 + r * NGW;
            float s = 0.f;
#pragma unroll
            for (int j = 0; j < 4; ++j) s += (v[r][j].x * v[r][j].x + v[r][j].y * v[r][j].y) + (v[r][j].z * v[r][j].z + v[r][j].w * v[r][j].w);
            s = rows_sum(sum16(s));
            const float ms = s * (1.0f / DM) + 1e-6f, rs = __builtin_amdgcn_rsqf(ms);
            if (m < MROWS) {
                GAS unsigned long long* o8 = (GAS unsigned long long*)(XB + (size_t)m * DM) + F.lane;
#pragma unroll
                for (int j = 0; j < 4; ++j) o8[64 * j] = (unsigned long long)pk2(v[r][j].x * rs, v[r][j].y * rs) | ((unsigned long long)pk2(v[r][j].z * rs, v[r][j].w * rs) << 32);
                if (F.lane == 0) RI0[m] = ms * rs;
            }
        }
    }
}

typedef short v4i16_t __attribute__((ext_vector_type(4)));
typedef unsigned u32x2_t __attribute__((ext_vector_type(2)));
__device__ __forceinline__ v4i16_t vtr(const LAS unsigned char* p) { return __builtin_amdgcn_ds_read_tr16_b64_v4i16((LAS v4i16_t*)p); }
constexpr int ATT_V = 32768, ATT_BUF = 65536;
__device__ __forceinline__ void glds16(const void* gsrc, unsigned lds_dst) {
    unsigned keep;
    asm volatile("s_mov_b32 %0, m0\n\ts_mov_b32 m0, %2\n\ts_nop 0\n\tglobal_load_lds_dwordx4 %1, off\n\ts_mov_b32 m0, %0" : "=&s"(keep) : "v"(gsrc), "s"(lds_dst) : "memory");
}
struct UnitP { int tok0, dil, s, rho; };
__device__ __forceinline__ UnitP unit_params(int k, int S2) {
    UnitP u; const int br = k >> 4, lb = k & 15;
    if (br == 0) { u.s = S2 * 16 + lb; u.rho = 0; u.dil = 1; u.tok0 = (u.s - 1) * 128; }
    else if (br == 1) { u.s = S2 * 4 + (lb >> 2); u.rho = lb & 3; u.dil = 4; u.tok0 = (u.s - 1) * 512 + u.rho; }
    else { u.s = S2; u.rho = lb; u.dil = 16; u.tok0 = (S2 - 1) * 2048 + lb; }
    return u;
}
__device__ __forceinline__ void attn_dma(unsigned ldsb, const bf16* Kg, const bf16* Vg, int rowbase, int h, const UnitP& u, int wave, int lane) {
    const int slot = lane & 7, lr = lane >> 3;
    const int lc = (((slot >> 1) ^ ((lr >> 1) & 3)) << 1) | ((slot ^ lr) & 1);
#pragma unroll
    for (int i = 0; i < 4; ++i) {
        const int p = wave + 8 * i, row = 8 * p + lr;
        int tok = u.tok0 + row * u.dil; tok = tok < 0 ? 0 : tok;
        const size_t off = ((((size_t)(rowbase >> 13) * 8 + h) * 16 + (tok & 15)) * 512 + (tok >> 4)) * 64 + lc * 8;
        const unsigned dst = (unsigned)__builtin_amdgcn_readfirstlane((int)(ldsb + p * 1024));
        glds16(Kg + off, dst); glds16(Vg + off, dst + ATT_V);
    }
}
template <int BR>
__device__ __forceinline__ void attn_compute(const LAS unsigned char* lds, bf16x8 q0, bf16x8 q1, bf16* PO, float* PL, int rowbase, int h, int s, int rho, int wave, int lane,
                                             u32x2_t (&ow)[4], float& olse, bf16*& optr, float*& olptr) {
    constexpr int dil = BR == 0 ? 1 : BR == 1 ? 4 : 16, span = 128 * dil;
    const int ii = lane & 15, g = lane >> 4, w = wave;
    const int tq = s * span + rho + (16 * w + ii) * dil;
    const size_t qrow = (size_t)(rowbase + tq);
    const int xk = (ii >> 1) & 3;
    const LAS unsigned char* kbase = lds + ((16 * w + ii) * 128 + ((g ^ ii) & 1) * 16);
    const LAS unsigned char* kb0 = kbase + ((((g >> 1)) ^ xk) << 5); const LAS unsigned char* kb1 = kbase + ((((g >> 1) + 2) ^ xk) << 5);
    f32x4 sc[9];
    {
        bf16x8 kf0[9], kf1[9];
#pragma unroll
        for (int kt = 0; kt < 9; ++kt) { kf0[kt] = *(const LAS bf16x8*)(kb0 + kt * 2048); kf1[kt] = *(const LAS bf16x8*)(kb1 + kt * 2048); }
        __builtin_amdgcn_sched_barrier(0);
#pragma unroll
        for (int kt = 0; kt < 9; ++kt) sc[kt] = __builtin_amdgcn_mfma_f32_16x16x32_bf16(kf0[kt], q0, (f32x4){0.f, 0.f, 0.f, 0.f}, 0, 0, 0);
#pragma unroll
        for (int kt = 0; kt < 9; ++kt) sc[kt] = __builtin_amdgcn_mfma_f32_16x16x32_bf16(kf1[kt], q1, sc[kt], 0, 0, 0);
    }
    const int qv = ii >> 2, pp = ii & 3, xv = (2 * g + (qv >> 1)) & 3;
    const LAS unsigned char* vbase = lds + ATT_V + ((16 * w + 4 * g + qv) * 128 + 8 * (pp ^ ((qv & 1) << 1)));
    v4i16_t vlo[5][4], vhi[5][4];
#pragma unroll
    for (int p = 0; p < 5; ++p)
#pragma unroll
        for (int db = 0; db < 4; ++db) { const LAS unsigned char* vb = vbase + ((db ^ xv) << 5) + p * 4096; vlo[p][db] = vtr(vb); vhi[p][db] = vtr(vb + (p < 4 ? 2048 : 0)); }
    __builtin_amdgcn_sched_barrier(0);
    const float NEG = -INFINITY;
#pragma unroll
    for (int r = 0; r < 4; ++r) { if (4 * g + r < ii) sc[0][r] = NEG; if (4 * g + r > ii) sc[8][r] = NEG; }
    if (s == 0) {
#pragma unroll
        for (int kt = 0; kt < 8; ++kt)
#pragma unroll
            for (int r = 0; r < 4; ++r) if (16 * w + 16 * kt + 4 * g + r < 128) sc[kt][r] = NEG;
    }
    float mx = NEG;
#pragma unroll
    for (int kt = 0; kt < 9; ++kt) mx = fmaxf(mx, fmaxf(fmaxf(sc[kt][0], sc[kt][1]), fmaxf(sc[kt][2], sc[kt][3])));
    mx = rows_max(mx);
    float ls = 0.f;
#pragma unroll
    for (int kt = 0; kt < 9; ++kt)
#pragma unroll
        for (int r = 0; r < 4; ++r) { const float p = __builtin_amdgcn_exp2f(sc[kt][r] - mx); sc[kt][r] = p; ls += p; }
    ls = rows_sum(ls);
    f32x4 o[4];
#pragma unroll
    for (int db = 0; db < 4; ++db) o[db] = (f32x4){0.f, 0.f, 0.f, 0.f};
#pragma unroll
    for (int p = 0; p < 5; ++p) {
        pg8::u32x4 pw;
        pw.x = pg8::cvt_pk_bf16(sc[2 * p][0], sc[2 * p][1]); pw.y = pg8::cvt_pk_bf16(sc[2 * p][2], sc[2 * p][3]);
        if (p < 4) { pw.z = pg8::cvt_pk_bf16(sc[2 * p + 1][0], sc[2 * p + 1][1]); pw.w = pg8::cvt_pk_bf16(sc[2 * p + 1][2], sc[2 * p + 1][3]); } else { pw.z = 0u; pw.w = 0u; }
        const bf16x8 pb = __builtin_bit_cast(bf16x8, pw);
#pragma unroll
        for (int db = 0; db < 4; ++db) {
            const v4i16_t lo = vlo[p][db], hi = vhi[p][db];
            const bf16x8 va = (bf16x8){lo[0], lo[1], lo[2], lo[3], hi[0], hi[1], hi[2], hi[3]};
            o[db] = __builtin_amdgcn_mfma_f32_16x16x32_bf16(va, pb, o[db], 0, 0, 0);
        }
    }
    const float linv = __builtin_amdgcn_rcpf(ls);
    const float lse = mx + __builtin_amdgcn_logf(ls);
    optr = PO + (size_t)BR * ((size_t)MP * 512) + qrow * 512 + h * 64 + 4 * g;
#pragma unroll
    for (int db = 0; db < 4; ++db) { ow[db].x = pg8::cvt_pk_bf16(o[db][0] * linv, o[db][1] * linv); ow[db].y = pg8::cvt_pk_bf16(o[db][2] * linv, o[db][3] * linv); }
    olse = lse; olptr = PL + (size_t)BR * ((size_t)MP * 8) + qrow * 8 + h;
}
#define ATT_TOP_WAIT(N) asm volatile("s_waitcnt vmcnt(" #N ") lgkmcnt(0)\n\ts_barrier" ::: "memory")
struct AUnit { int b, h, s, rho, dil, tok0; };
__device__ __forceinline__ AUnit aunit(int xcd, int j, int pp, int i) {
    AUnit u; const int bh = xcd + 8 * pp, v = (j + 32 * i) & 63, br = i >> 1;
    u.b = bh >> 3; u.h = bh & 7;
    if (br == 0) { u.dil = 1; u.s = v; u.rho = 0; u.tok0 = (v - 1) * 128; }
    else if (br == 1) { u.dil = 4; u.s = v >> 2; u.rho = v & 3; u.tok0 = (u.s - 1) * 512 + u.rho; }
    else { u.dil = 16; u.s = v >> 4; u.rho = v & 15; u.tok0 = (u.s - 1) * 2048 + u.rho; }
    return u;
}
__device__ __forceinline__ void attn_units(Frame& F, unsigned char* ws) {
    const int xcd = (F.vcu >> 5) & 7, j = F.vcu & 31;
    const bf16* Qg = (const bf16*)(ws + WS_Z); const bf16* Kg = Qg + (size_t)MROWS * 512; const bf16* Vg = Kg + (size_t)MROWS * 512;
    bf16* PO = (bf16*)(ws + WS_PO); float* PL = (float*)(ws + WS_PL);
    const LAS unsigned char* lds = F.lds + RING_OFF;
    const unsigned ldsb = (unsigned)(uintptr_t)(F.lds + RING_OFF);
    const int ii = F.lane & 15, g = F.lane >> 4;
    const LAS unsigned char* qw = F.lds + QBUF_OFF + F.wave * 2048;
    const unsigned qwb = (unsigned)__builtin_amdgcn_readfirstlane((int)(unsigned)(uintptr_t)qw);
    const unsigned wwb = (unsigned)__builtin_amdgcn_readfirstlane((int)(unsigned)(uintptr_t)(F.lds + WARM_OFF + F.wave * 256));
#define ATT_QDMA(U) do { _Pragma("unroll") for (int j_ = 0; j_ < 2; ++j_) { const int tq_ = (U).s * 128 * (U).dil + (U).rho + (16 * F.wave + 8 * j_ + (F.lane >> 3)) * (U).dil; \
        glds16(Qg + (size_t)((U).b * SEQ + tq_) * 512 + (U).h * 64 + ((F.lane ^ (F.lane >> 3)) & 7) * 8, qwb + j_ * 1024); } } while (0)
#define ATT_QREAD() do { q0 = *(const LAS bf16x8*)(qw + ii * 128 + 16 * (g ^ (ii & 7))); q1 = *(const LAS bf16x8*)(qw + ii * 128 + 16 * ((4 + g) ^ (ii & 7))); LDS_WAIT(); } while (0)
#define ATT_WARM(U) do { const int tq_ = (U).s * 128 * (U).dil + (U).rho + (16 * F.wave + ii) * (U).dil; const bf16* wp_ = Qg + (size_t)((U).b * SEQ + tq_) * 512 + (U).h * 64 + g * 16; unsigned keep_; \
        asm volatile("s_mov_b32 %0, m0\n\ts_mov_b32 m0, %2\n\ts_nop 0\n\tglobal_load_lds_dword %1, off\n\ts_mov_b32 m0, %0" : "=&s"(keep_) : "v"(wp_), "s"(wwb) : "memory"); } while (0)
#define ATT_DMA(U, BUF) do { UnitP up_; up_.tok0 = (U).tok0; up_.dil = (U).dil; up_.s = (U).s; up_.rho = (U).rho; attn_dma(ldsb + (BUF) * ATT_BUF, Kg, Vg, (U).b * SEQ, (U).h, up_, F.wave, F.lane); } while (0)
#define ATT_UNIT(NK) aunit(xcd, j, (NK) / 6, (NK) % 6)
    AUnit u = ATT_UNIT(0), un = u;
    bf16x8 q0, q1;
    u32x2_t pw[4]; float plse = 0.f; bf16* pptr = nullptr; float* plptr = nullptr;
#pragma unroll
    for (int db = 0; db < 4; ++db) pw[db] = (u32x2_t){0u, 0u};
#define ATT_FLUSH() do { if (pptr) { _Pragma("unroll") for (int db_ = 0; db_ < 4; ++db_) *(u32x2_t*)(pptr + 16 * db_) = pw[db_]; if (g == 0) *plptr = plse; pptr = nullptr; } } while (0)
    ATT_QDMA(u); ATT_DMA(u, 0); { const AUnit uw_ = ATT_UNIT(1); ATT_WARM(uw_); }
#define ATT_STEP(BR, K) do { \
        ATT_TOP_WAIT(1); \
        ATT_QREAD(); \
        ATT_FLUSH(); \
        { const int nk_ = (K) + 1; if (nk_ < 48) { un = ATT_UNIT(nk_); ATT_DMA(un, nk_ & 1); ATT_QDMA(un); } \
          const int wk_ = nk_ + 1 < 48 ? nk_ + 1 : 47; const AUnit uw_ = ATT_UNIT(wk_); ATT_WARM(uw_); } \
        attn_compute<BR>(lds + ((K) & 1) * ATT_BUF, q0, q1, PO, PL, u.b * SEQ, u.h, u.s, u.rho, F.wave, F.lane, pw, plse, pptr, plptr); \
        u = un; } while (0)
#pragma unroll 1
    for (int pp = 0; pp < 8; ++pp) {
#pragma unroll 1
        for (int e = 0; e < 2; ++e) ATT_STEP(0, 6 * pp + e);
#pragma unroll 1
        for (int e = 2; e < 4; ++e) ATT_STEP(1, 6 * pp + e);
#pragma unroll 1
        for (int e = 4; e < 6; ++e) ATT_STEP(2, 6 * pp + e);
    }
    ATT_FLUSH();
    VM_WAIT(); LDS_WAIT(); __builtin_amdgcn_s_barrier(); asm volatile("" ::: "memory");
#undef ATT_STEP
#undef ATT_FLUSH
#undef ATT_UNIT
#undef ATT_DMA
#undef ATT_WARM
#undef ATT_QREAD
#undef ATT_QDMA
}
__device__ __forceinline__ void attn_merge(Frame& F, unsigned char* ws) {
    const bf16* PO = (const bf16*)(ws + WS_PO); const float* PL = (const float*)(ws + WS_PL); bf16* MIX = (bf16*)(ws + WS_MIX);
    const int NT = F.G * NWAVES * 64, gt = (F.vcu * NWAVES + F.wave) * 64 + F.lane;
#pragma unroll 4
    for (int idx = gt; idx < MP * 64; idx += NT) {
        const size_t qrow = (size_t)(MP - 1 - (idx >> 6)); const int h = (idx >> 3) & 7, dg = (idx & 7) * 8;
        const float l0 = PL[qrow * 8 + h], l1 = PL[(size_t)MP * 8 + qrow * 8 + h], l2 = PL[(size_t)2 * MP * 8 + qrow * 8 + h];
        const v4u a = *(const v4u*)(PO + qrow * 512 + h * 64 + dg), bb = *(const v4u*)(PO + (size_t)MP * 512 + qrow * 512 + h * 64 + dg), c = *(const v4u*)(PO + (size_t)2 * MP * 512 + qrow * 512 + h * 64 + dg);
        const float mm = fmaxf(fmaxf(l0, l1), l2);
        const float w0 = __builtin_amdgcn_exp2f(l0 - mm), w1 = __builtin_amdgcn_exp2f(l1 - mm), w2 = __builtin_amdgcn_exp2f(l2 - mm);
        const float wi = __builtin_amdgcn_rcpf(w0 + w1 + w2), c0 = w0 * wi, c1 = w1 * wi, c2 = w2 * wi;
#define ATT_MRG(F_) pg8::cvt_pk_bf16(c0 * __builtin_bit_cast(float, a.F_ << 16) + c1 * __builtin_bit_cast(float, bb.F_ << 16) + c2 * __builtin_bit_cast(float, c.F_ << 16), \
                                     c0 * __builtin_bit_cast(float, a.F_ & 0xffff0000u) + c1 * __builtin_bit_cast(float, bb.F_ & 0xffff0000u) + c2 * __builtin_bit_cast(float, c.F_ & 0xffff0000u))
        v4u o; o.x = ATT_MRG(x); o.y = ATT_MRG(y); o.z = ATT_MRG(z); o.w = ATT_MRG(w);
#undef ATT_MRG
        *(v4u*)(MIX + qrow * 1024 + h * 64 + dg) = o;
    }
}
constexpr int SRING = 9, SW_BYTES = SRING * 2048;
static_assert(NWAVES * SW_BYTES <= LDSCTL_OFF && 2 * SRING - 2 == 16, "sample ring");
__device__ __forceinline__ void attn_sample_item(LAS unsigned char* wl, const In& in, unsigned char* ws, float* outp, int b, int hq, int t, int lane) {
    const int i = lane & 15, g = lane >> 4;
    const bf16* Qg = (const bf16*)(ws + WS_Z);
    const size_t srow = (size_t)MP + b * DECT + t;
    const u32x2_t qw = *(const u32x2_t*)(Qg + srow * 512 + hq * 256 + 4 * lane);
    const float q0 = __builtin_bit_cast(float, qw.x << 16), q1 = __builtin_bit_cast(float, qw.x & 0xffff0000u), q2 = __builtin_bit_cast(float, qw.y << 16), q3 = __builtin_bit_cast(float, qw.y & 0xffff0000u);
    const float* ckb = in.p[2] + (size_t)b * WBUF * 512 + hq * 256; const float* cvb = in.p[3] + (size_t)b * WBUF * 512 + hq * 256;
    const float* nk = outp + O_KNS + (size_t)b * DECT * 512 + hq * 256; const float* nv = outp + O_VNS + (size_t)b * DECT * 512 + hq * 256;
    float m = -1e30f, l = 0.f; f32x4 o = (f32x4){0.f, 0.f, 0.f, 0.f};
    {
        const int cnt = t + 3 + (t >= 4 ? 1 : 0);
        float scn[11]; f32x4 vn[11];
#pragma unroll
        for (int e = 0; e < 11; ++e) {
            int tp = (e <= t) ? t - e : (e == t + 3 ? t - 4 : t); tp = tp < 0 ? 0 : tp;
            const unsigned off = (unsigned)(tp * 512 + 4 * lane);
            const f32x4 kv = *(const f32x4*)(nk + off); vn[e] = *(const f32x4*)(nv + off);
            const float sc = sum16((q0 * kv[0] + q1 * kv[1]) + (q2 * kv[2] + q3 * kv[3]));
            scn[e] = (e < cnt) ? sc : -INFINITY;
            m = fmaxf(m, scn[e]);
        }
#pragma unroll
        for (int e = 0; e < 11; ++e) { const float p = __builtin_amdgcn_exp2f(scn[e] - m); l += p; o = o + vn[e] * p; }
    }
#define S_SRC(PI, BASE) ({ const int pi_ = (PI) > 386 ? 386 : (PI); const int br_ = pi_ / 129, j_ = pi_ - 129 * br_; \
        int idx_ = WBUF + t - (j_ << (2 * br_)); idx_ = idx_ < 0 ? 0 : (idx_ >= WBUF ? WBUF - 1 : idx_); (BASE) + (unsigned)(idx_ * 512 + 4 * lane); })
    const unsigned wlb = (unsigned)__builtin_amdgcn_readfirstlane((int)(unsigned)(uintptr_t)wl);
#pragma unroll
    for (int n = 0; n < SRING; ++n) { glds16(S_SRC(n, ckb), wlb + n * 2048); glds16(S_SRC(n, cvb), wlb + n * 2048 + 1024); }
#pragma unroll 1
    for (int pi = 0; pi < 387; ++pi) {
        asm volatile("s_waitcnt vmcnt(16)" ::: "memory");
        const int sb = (pi % SRING) * 2048;
        const f32x4 kv = *(const LAS f32x4*)(wl + sb + lane * 16), vv = *(const LAS f32x4*)(wl + sb + 1024 + lane * 16);
        LDS_WAIT();
        glds16(S_SRC(pi + SRING, ckb), wlb + sb); glds16(S_SRC(pi + SRING, cvb), wlb + sb + 1024);
        const int br = pi / 129, j = pi - 129 * br;
        float sv = sum16((q0 * kv[0] + q1 * kv[1]) + (q2 * kv[2] + q3 * kv[3]));
        if ((j << (2 * br)) <= t) sv = -INFINITY;
        const float mn = fmaxf(m, sv), f = __builtin_amdgcn_exp2f(m - mn), pv = __builtin_amdgcn_exp2f(sv - mn);
        l = l * f + pv; o = o * f + vv * pv; m = mn;
    }
    asm volatile("s_waitcnt vmcnt(0)" ::: "memory");
#undef S_SRC
    {
        const float li = __builtin_amdgcn_rcpf(l);
        u32x2_t wv; wv.x = pg8::cvt_pk_bf16(o[0] * li, o[1] * li); wv.y = pg8::cvt_pk_bf16(o[2] * li, o[3] * li);
        *(u32x2_t*)((bf16*)(ws + WS_MIX) + srow * 1024 + hq * 256 + 4 * lane) = wv;
    }
}

constexpr int RW_BYTES = 16384, RW_XCB_PITCH = 144, RW_PITCH = 68;
constexpr int RW_XCF = 16 * RW_XCB_PITCH, RW_AL = RW_XCF + 16 * RW_PITCH * 4, RW_BL = RW_AL + 16 * RW_PITCH * 4;
static_assert(RW_BL + 16 * RW_PITCH * 4 <= RW_BYTES && NWAVES * RW_BYTES <= RING_BYTES, "rnn LDS");
template <bool PASS2>
__device__ __forceinline__ void rnn_wave_item(LAS unsigned char* wl, const In& in, unsigned char* ws, int n, size_t row0, int ntok, float hu3, float hu2, float hu1, float h0, float& ra, float& rb, float (&hu)[3], int lane) {
    const bf16* Ub = (const bf16*)(ws + WS_Z) + (size_t)3 * MROWS * 512 + 64 * n + lane; const bf16* Gb = Ub + (size_t)MROWS * 512;
    bf16* MIX = (bf16*)(ws + WS_MIX) + 512 + 64 * n + lane;
    const int ch = 64 * n + lane, i = lane & 15, g = lane >> 4;
    const float cw0 = in.p[12][ch], cw1 = in.p[12][512 + ch], cw2 = in.p[12][1024 + ch], cw3 = in.p[12][1536 + ch], cb = in.p[13][ch];
    float ba[4], bx[4], sp8[4]; bf16x8 wa[4][2], wx[4][2];
    const bf16* WA = (const bf16*)(ws + WS_WGA) + n * 4096; const bf16* WX = (const bf16*)(ws + WS_WGX) + n * 4096;
#pragma unroll
    for (int db = 0; db < 4; ++db) {
        const int c = 64 * n + 16 * db + i;
        ba[db] = -1.4426950408889634f * in.p[15][c]; bx[db] = -1.4426950408889634f * in.p[17][c];
        sp8[db] = -8.0f * 1.4426950408889634f * log1pf(expf(-in.p[18][c]));
#pragma unroll
        for (int ks = 0; ks < 2; ++ks) { wa[db][ks] = *(const bf16x8*)(WA + (16 * db + i) * 64 + 8 * g + 32 * ks); wx[db][ks] = *(const bf16x8*)(WX + (16 * db + i) * 64 + 8 * g + 32 * ks); }
    }
    float u3 = hu3, u2 = hu2, u1 = hu1, h = h0, P = 1.0f;
    typedef float f32x2_t __attribute__((ext_vector_type(2)));
    LAS float* XCF = (LAS float*)(wl + RW_XCF); LAS f32x2_t* AB = (LAS f32x2_t*)(wl + RW_AL);
    const int nsub = (ntok + 15) >> 4;
    unsigned short uraw[16], graw[16];
#pragma unroll
    for (int tt = 0; tt < 16; ++tt) { uraw[tt] = (tt < ntok) ? Ub[(row0 + tt) * 512] : (unsigned short)0; graw[tt] = (PASS2 && tt < ntok) ? Gb[(row0 + tt) * 512] : (unsigned short)0; }
    for (int sb = 0; sb < nsub; ++sb) {
        const int nv = (ntok - 16 * sb) < 16 ? (ntok - 16 * sb) : 16;
        const size_t r0 = row0 + 16 * sb;
        unsigned short unx[16], gnx[16];
        const bool more = (sb + 1 < nsub);
#pragma unroll
        for (int tt = 0; tt < 16; ++tt) { unx[tt] = more ? Ub[(r0 + 16 + tt) * 512] : (unsigned short)0; gnx[tt] = (PASS2 && more) ? Gb[(r0 + 16 + tt) * 512] : (unsigned short)0; }
#pragma unroll
        for (int tt = 0; tt < 16; ++tt) {
            float xc = 0.f;
            if (tt < nv) { const float u0 = bf2f(uraw[tt]); xc = cb + cw0 * u3 + cw1 * u2 + cw2 * u1 + cw3 * u0; u3 = u2; u2 = u1; u1 = u0; }
            XCF[tt * RW_PITCH + lane] = xc;
            *(LAS unsigned short*)(wl + tt * RW_XCB_PITCH + lane * 2) = __builtin_bit_cast(unsigned short, (__bf16)xc);
        }
        LDS_WAIT(); asm volatile("" ::: "memory");
        {
            const bf16x8 a0 = *(const LAS bf16x8*)(wl + i * RW_XCB_PITCH + 16 * g), a1 = *(const LAS bf16x8*)(wl + i * RW_XCB_PITCH + 16 * g + 64);
#pragma unroll
            for (int db = 0; db < 4; ++db) {
                f32x4 da = (f32x4){0.f, 0.f, 0.f, 0.f}, dx = (f32x4){0.f, 0.f, 0.f, 0.f};
                da = __builtin_amdgcn_mfma_f32_16x16x32_bf16(a0, wa[db][0], da, 0, 0, 0); da = __builtin_amdgcn_mfma_f32_16x16x32_bf16(a1, wa[db][1], da, 0, 0, 0);
                dx = __builtin_amdgcn_mfma_f32_16x16x32_bf16(a0, wx[db][0], dx, 0, 0, 0); dx = __builtin_amdgcn_mfma_f32_16x16x32_bf16(a1, wx[db][1], dx, 0, 0, 0);
                const int c = 16 * db + i;
#pragma unroll
                for (int r = 0; r < 4; ++r) {
                    const int tok = 4 * g + r;
                    const float xcv = XCF[tok * RW_PITCH + c];
                    const float rg = __builtin_amdgcn_rcpf(1.0f + __builtin_amdgcn_exp2f(da[r] + ba[db])), ig = __builtin_amdgcn_rcpf(1.0f + __builtin_amdgcn_exp2f(dx[r] + bx[db]));
                    const float l2a = rg * sp8[db];
                    const float a = __builtin_amdgcn_exp2f(l2a);
                    const float em = __builtin_fmaf(-a, a, 1.0f);
                    const float bt = __builtin_amdgcn_sqrtf(em) * ig * xcv;
                    AB[tok * RW_PITCH + c] = (f32x2_t){a, bt};
                }
            }
        }
        LDS_WAIT(); asm volatile("" ::: "memory");
        if (PASS2) {
#pragma unroll
            for (int tt = 0; tt < 16; ++tt) if (tt < nv) {
                { const f32x2_t ab = AB[tt * RW_PITCH + lane]; h = ab.x * h + ab.y; }
                const float gv = bf2f(graw[tt]);
                const float z2 = gv * (-2.3022082f + -0.10294324f * (gv * gv));
                MIX[(r0 + tt) * 1024] = (bf16)f2bf(h * gv * __builtin_amdgcn_rcpf(1.0f + __builtin_amdgcn_exp2f(z2)));
            }
        } else {
#pragma unroll
            for (int tt = 0; tt < 16; ++tt) if (tt < nv) { const f32x2_t ab = AB[tt * RW_PITCH + lane]; h = ab.x * h + ab.y; P *= ab.x; }
        }
        LDS_WAIT(); asm volatile("" ::: "memory");
#pragma unroll
        for (int tt = 0; tt < 16; ++tt) { uraw[tt] = unx[tt]; graw[tt] = gnx[tt]; }
    }
    ra = P; rb = h; hu[0] = u3; hu[1] = u2; hu[2] = u1;
}

template <bool BB, bool OF, bool OB>
__device__ __forceinline__ void sgk_resid(Frame& F, const bf16* A, int K, const bf16* Wt, const float* xs  , bf16* XB, float* outf, float* ss, float alpha) {
    const int i = F.lane & 15, g = F.lane >> 4, w = F.wave;
    LAS float* part = (LAS float*)(F.lds + RING_OFF);
    const int Ks = K >> 3, nsteps = Ks >> 5;
    for (int tile = F.vcu; tile < (MS / 64) * (DM / 64); tile += F.G) {
        const int rt = tile >> 4, ct = tile & 15, arow0 = MP + rt * 64, c0 = ct * 64;
        f32x4 acc[4][4];
#pragma unroll
        for (int bq = 0; bq < 4; ++bq)
#pragma unroll
            for (int ar = 0; ar < 4; ++ar) acc[bq][ar] = (f32x4){0.f, 0.f, 0.f, 0.f};
        const bf16* ap = A + (size_t)(arow0 + i) * K + w * Ks + 8 * g;
        const bf16* bp = Wt + (size_t)(c0 + i) * K + w * Ks + 8 * g;
#pragma unroll 1
        for (int s0 = 0; s0 < nsteps; s0 += 4) {
            bf16x8 fa[4][4], fb[4][4];
#pragma unroll
            for (int st = 0; st < 4; ++st) {
                const int step = (s0 + st < nsteps) ? s0 + st : nsteps - 1;
#pragma unroll
                for (int q = 0; q < 4; ++q) { fa[st][q] = *(const bf16x8*)(ap + (size_t)q * 16 * K + 32 * step); fb[st][q] = *(const bf16x8*)(bp + (size_t)q * 16 * K + 32 * step); }
            }
            __builtin_amdgcn_sched_barrier(0);
#pragma unroll
            for (int st = 0; st < 4; ++st) if (s0 + st < nsteps) {
#pragma unroll
                for (int bq = 0; bq < 4; ++bq)
#pragma unroll
                    for (int ar = 0; ar < 4; ++ar) acc[bq][ar] = __builtin_amdgcn_mfma_f32_16x16x32_bf16(fb[st][bq], fa[st][ar], acc[bq][ar], 0, 0, 0);
            }
        }
#pragma unroll
        for (int bq = 0; bq < 4; ++bq)
#pragma unroll
            for (int ar = 0; ar < 4; ++ar) *(LAS f32x4*)(part + ((w * 64 + 16 * ar + i) * 64 + 16 * bq + 4 * g)) = acc[bq][ar];
        __syncthreads();
        {
            const int row = F.tid >> 3, c8 = (F.tid & 7) * 8, grow = arow0 + row, col = c0 + c8;
            f32x4 s0v = (f32x4){0.f, 0.f, 0.f, 0.f}, s1v = s0v;
#pragma unroll
            for (int ww = 0; ww < 8; ++ww) { const LAS f32x4* pp = (const LAS f32x4*)(part + ((ww * 64 + row) * 64 + c8)); s0v = s0v + pp[0]; s1v = s1v + pp[1]; }
            const size_t off = (size_t)grow * DM + col;
            f32x4 b0, b1;
            if (BB) { const v4u wv = *(const v4u*)(XB + off);
                b0 = (f32x4){__builtin_bit_cast(float, wv.x << 16), __builtin_bit_cast(float, wv.x & 0xffff0000u), __builtin_bit_cast(float, wv.y << 16), __builtin_bit_cast(float, wv.y & 0xffff0000u)};
                b1 = (f32x4){__builtin_bit_cast(float, wv.z << 16), __builtin_bit_cast(float, wv.z & 0xffff0000u), __builtin_bit_cast(float, wv.w << 16), __builtin_bit_cast(float, wv.w & 0xffff0000u)}; }
            else { const f32x4* xp = (const f32x4*)(xs + (size_t)(grow - MP) * DM + col); b0 = xp[0]; b1 = xp[1]; }
            const f32x4 o0 = b0 + s0v * alpha, o1 = b1 + s1v * alpha;
            if (OF) { *(f32x4*)(outf + off) = o0; *(f32x4*)(outf + off + 4) = o1; }
            if (OB) { v4u wv; wv.x = pg8::cvt_pk_bf16(o0[0], o0[1]); wv.y = pg8::cvt_pk_bf16(o0[2], o0[3]); wv.z = pg8::cvt_pk_bf16(o1[0], o1[1]); wv.w = pg8::cvt_pk_bf16(o1[2], o1[3]); *(v4u*)(XB + off) = wv; }
            float q = ((o0[0] * o0[0] + o0[1] * o0[1]) + (o0[2] * o0[2] + o0[3] * o0[3])) + ((o1[0] * o1[0] + o1[1] * o1[1]) + (o1[2] * o1[2] + o1[3] * o1[3]));
            q += dppmov<0xB1>(q); q += dppmov<0x4E>(q); q += dppmov<0x141>(q);
            if ((F.tid & 7) == 0) ss[(size_t)grow * 16 + ct] = q;
        }
        __syncthreads();
    }
}

constexpr int PT_OFF = QBUF_OFF;
static_assert(MISC_OFF + 128 <= LDS_BYTES, "LDS map");

__device__ __forceinline__ void phase_0(Frame& F, const In& in, unsigned char* ws, float* outp) {
    bf16* XB = (bf16*)(ws + WS_XB); bf16* HB = (bf16*)(ws + WS_H); bf16* ZB = (bf16*)(ws + WS_Z); bf16* MIXB = (bf16*)(ws + WS_MIX);
    float* SS0 = (float*)(ws + WS_SS0); float* SS1 = (float*)(ws + WS_SS1); float* SS2 = (float*)(ws + WS_SS2); float* SS3 = (float*)(ws + WS_SS3);
    (void)XB; (void)HB; (void)ZB; (void)MIXB; (void)SS0; (void)SS1; (void)SS2; (void)SS3;
        p0_prologue(F, in, ws);
}
__device__ __forceinline__ void phase_1(Frame& F, const In& in, unsigned char* ws, float* outp) {
    bf16* XB = (bf16*)(ws + WS_XB); bf16* HB = (bf16*)(ws + WS_H); bf16* ZB = (bf16*)(ws + WS_Z); bf16* MIXB = (bf16*)(ws + WS_MIX);
    float* SS0 = (float*)(ws + WS_SS0); float* SS1 = (float*)(ws + WS_SS1); float* SS2 = (float*)(ws + WS_SS2); float* SS3 = (float*)(ws + WS_SS3);
    (void)XB; (void)HB; (void)ZB; (void)MIXB; (void)SS0; (void)SS1; (void)SS2; (void)SS3;
        pg8::Gemm g{XB, (const bf16*)(ws + WS_W1GU), MROWS, NGU, DM}; pg8::StaticOrder S; S.init(MROWS, NGU, F.G, (int)blockIdx.x);
        pg8::EpiSwiGLU<false> E{HB, nullptr, DFF, nullptr};
        pg8::gemm_phase<pg8::EpiSwiGLU<false>, pg8::StaticOrder, true, true>(F.lds + RING_OFF, g, S, E);
}
__device__ __forceinline__ void phase_2(Frame& F, const In& in, unsigned char* ws, float* outp) {
    bf16* XB = (bf16*)(ws + WS_XB); bf16* HB = (bf16*)(ws + WS_H); bf16* ZB = (bf16*)(ws + WS_Z); bf16* MIXB = (bf16*)(ws + WS_MIX);
    float* SS0 = (float*)(ws + WS_SS0); float* SS1 = (float*)(ws + WS_SS1); float* SS2 = (float*)(ws + WS_SS2); float* SS3 = (float*)(ws + WS_SS3);
    (void)XB; (void)HB; (void)ZB; (void)MIXB; (void)SS0; (void)SS1; (void)SS2; (void)SS3;
        pg8::Gemm g{HB, (const bf16*)(ws + WS_W1D), MP, DM, DFF}; pg8::StaticOrder S; S.init(MP, DM, F.G, (int)blockIdx.x); S.rev = 1;
        pg8::EpiResid<false, false, true, false> E{in.p[0], nullptr, nullptr, XB, SS1, nullptr, 0.5f};
        pg8::gemm_phase<pg8::EpiResid<false, false, true, false>, pg8::StaticOrder, true, true>(F.lds + RING_OFF, g, S, E);
        sgk_resid<false, false, true>(F, HB, DFF, (const bf16*)(ws + WS_W1D), in.p[1], XB, nullptr, SS1, 0.5f);
}
__device__ __forceinline__ void phase_3(Frame& F, const In& in, unsigned char* ws, float* outp) {
    bf16* XB = (bf16*)(ws + WS_XB); bf16* HB = (bf16*)(ws + WS_H); bf16* ZB = (bf16*)(ws + WS_Z); bf16* MIXB = (bf16*)(ws + WS_MIX);
    float* SS0 = (float*)(ws + WS_SS0); float* SS1 = (float*)(ws + WS_SS1); float* SS2 = (float*)(ws + WS_SS2); float* SS3 = (float*)(ws + WS_SS3);
    (void)XB; (void)HB; (void)ZB; (void)MIXB; (void)SS0; (void)SS1; (void)SS2; (void)SS3;
        pg8::Gemm g{XB, (const bf16*)(ws + WS_WIN), MROWS, NIN, DM}; pg8::StaticOrder S; S.init(MROWS, NIN, F.G, (int)blockIdx.x);
        pg8::EpiZ E{ZB, SS1, outp, (LAS float*)(F.lds + PT_OFF)};
        pg8::gemm_phase<pg8::EpiZ, pg8::StaticOrder, true, true>(F.lds + RING_OFF, g, S, E);
}
__device__ __forceinline__ void phase_4(Frame& F, const In& in, unsigned char* ws, float* outp) {
    {
        LAS unsigned char* wl = F.lds + RING_OFF + F.wave * RW_BYTES;
        const int ch = 64 * F.wave + F.lane;
        const bf16* Ub = (const bf16*)(ws + WS_Z) + (size_t)3 * MROWS * 512;
        for (int ru = F.vcu; ru < BATCH * NCHUNK; ru += F.G) {
            const int c = ru % NCHUNK, row0 = (ru / NCHUNK) * SEQ + c * 256;
            float h3 = 0.f, h2 = 0.f, h1 = 0.f;
            if (c > 0) { h3 = bf2f(Ub[(size_t)(row0 - 3) * 512 + ch]); h2 = bf2f(Ub[(size_t)(row0 - 2) * 512 + ch]); h1 = bf2f(Ub[(size_t)(row0 - 1) * 512 + ch]); }
            float ra, rb, hu[3];
            rnn_wave_item<false>(wl, in, ws, F.wave, (size_t)row0, 256, h3, h2, h1, 0.f, ra, rb, hu, F.lane);
            ((float*)(ws + WS_RSA))[(size_t)ru * 512 + ch] = ra; ((float*)(ws + WS_RSB))[(size_t)ru * 512 + ch] = rb;
        }
        asm volatile("s_waitcnt vmcnt(0) lgkmcnt(0)" ::: "memory"); __syncthreads();
    }
    attn_units(F, ws);
}
__device__ __forceinline__ void phase_5(Frame& F, const In& in, unsigned char* ws, float* outp) {
    attn_merge(F, ws);
    LAS unsigned char* wl = F.lds + RING_OFF + F.wave * SW_BYTES;
    const int ch = 64 * F.wave + F.lane;
    const bf16* Ub = (const bf16*)(ws + WS_Z) + (size_t)3 * MROWS * 512;
#pragma unroll 1
    for (int half_ = 0; half_ < 2; ++half_) {
        const int half = half_ ^ ((F.wave >> 1) & 1);
        if (half == 0) {
            for (int ru = F.vcu; ru < BATCH * NCHUNK + DECB; ru += F.G) {
                float ra, rb, hu[3];
                if (ru < BATCH * NCHUNK) {
                    const int b = ru / NCHUNK, c = ru % NCHUNK, row0 = b * SEQ + c * 256;
                    float h3 = 0.f, h2 = 0.f, h1 = 0.f, h0 = 0.f;
                    if (c > 0) { h3 = bf2f(Ub[(size_t)(row0 - 3) * 512 + ch]); h2 = bf2f(Ub[(size_t)(row0 - 2) * 512 + ch]); h1 = bf2f(Ub[(size_t)(row0 - 1) * 512 + ch]); }
                    const float* RA = (const float*)(ws + WS_RSA) + (size_t)b * NCHUNK * 512 + ch; const float* RB = (const float*)(ws + WS_RSB) + (size_t)b * NCHUNK * 512 + ch;
                    {
                        float fa[NCHUNK - 1], fb[NCHUNK - 1];
#pragma unroll
                        for (int cc = 0; cc < NCHUNK - 1; ++cc) { const int ci = cc < c ? cc : 0; fa[cc] = RA[ci * 512]; fb[cc] = RB[ci * 512]; }
#pragma unroll
                        for (int cc = 0; cc < NCHUNK - 1; ++cc) h0 = cc < c ? fa[cc] * h0 + fb[cc] : h0;
                    }
                    rnn_wave_item<true>(wl, in, ws, F.wave, (size_t)row0, 256, h3, h2, h1, h0, ra, rb, hu, F.lane);
                    if (c == NCHUNK - 1) {
                        outp[O_LHP + b * 512 + ch] = rb;
                        outp[O_LCP + (b * 3 + 0) * 512 + ch] = hu[0]; outp[O_LCP + (b * 3 + 1) * 512 + ch] = hu[1]; outp[O_LCP + (b * 3 + 2) * 512 + ch] = hu[2];
                    }
                } else {
                    const int b = ru - BATCH * NCHUNK, row0 = MP + b * DECT;
                    const float* cs = in.p[5] + (size_t)b * 3 * 512 + ch;
                    rnn_wave_item<true>(wl, in, ws, F.wave, (size_t)row0, DECT, cs[0], cs[512], cs[1024], in.p[4][b * 512 + ch], ra, rb, hu, F.lane);
                    outp[O_LHS + b * 512 + ch] = rb;
                    outp[O_LCS + (b * 3 + 0) * 512 + ch] = hu[0]; outp[O_LCS + (b * 3 + 1) * 512 + ch] = hu[1]; outp[O_LCS + (b * 3 + 2) * 512 + ch] = hu[2];
                }
            }
        } else {
            for (int pr = F.vcu + (F.wave >> 1) * F.G; pr < DECB * DECT; pr += 4 * F.G) attn_sample_item(wl, in, ws, outp, pr >> 3, F.wave & 1, pr & 7, F.lane);
        }
    }
}
__device__ __forceinline__ void phase_6(Frame& F, const In& in, unsigned char* ws, float* outp) {
    bf16* XB = (bf16*)(ws + WS_XB); bf16* HB = (bf16*)(ws + WS_H); bf16* ZB = (bf16*)(ws + WS_Z); bf16* MIXB = (bf16*)(ws + WS_MIX);
    float* SS0 = (float*)(ws + WS_SS0); float* SS1 = (float*)(ws + WS_SS1); float* SS2 = (float*)(ws + WS_SS2); float* SS3 = (float*)(ws + WS_SS3);
    (void)XB; (void)HB; (void)ZB; (void)MIXB; (void)SS0; (void)SS1; (void)SS2; (void)SS3;
        pg8::Gemm g{MIXB, (const bf16*)(ws + WS_WOUT), MP, DM, DM}; pg8::StaticOrder S; S.init(MP, DM, F.G, (int)blockIdx.x);
        pg8::EpiResid<true, false, true, false> E{nullptr, nullptr, nullptr, XB, SS2, nullptr, 1.0f};
        pg8::gemm_phase<pg8::EpiResid<true, false, true, false>, pg8::StaticOrder, true, true>(F.lds + RING_OFF, g, S, E);
        sgk_resid<true, false, true>(F, MIXB, DM, (const bf16*)(ws + WS_WOUT), nullptr, XB, nullptr, SS2, 1.0f);
}
__device__ __forceinline__ void phase_7(Frame& F, const In& in, unsigned char* ws, float* outp) {
    bf16* XB = (bf16*)(ws + WS_XB); bf16* HB = (bf16*)(ws + WS_H); bf16* ZB = (bf16*)(ws + WS_Z); bf16* MIXB = (bf16*)(ws + WS_MIX);
    float* SS0 = (float*)(ws + WS_SS0); float* SS1 = (float*)(ws + WS_SS1); float* SS2 = (float*)(ws + WS_SS2); float* SS3 = (float*)(ws + WS_SS3);
    (void)XB; (void)HB; (void)ZB; (void)MIXB; (void)SS0; (void)SS1; (void)SS2; (void)SS3;
        pg8::Gemm g{XB, (const bf16*)(ws + WS_W2GU), MROWS, NGU, DM}; pg8::StaticOrder S; S.init(MROWS, NGU, F.G, (int)blockIdx.x); S.rev = 1;
        pg8::EpiSwiGLU<true> E{HB, SS2, DFF, (LAS float*)(F.lds + PT_OFF)};
        pg8::gemm_phase<pg8::EpiSwiGLU<true>, pg8::StaticOrder, true, true>(F.lds + RING_OFF, g, S, E);
}
__device__ __forceinline__ void phase_8(Frame& F, const In& in, unsigned char* ws, float* outp) {
    bf16* XB = (bf16*)(ws + WS_XB); bf16* HB = (bf16*)(ws + WS_H); bf16* ZB = (bf16*)(ws + WS_Z); bf16* MIXB = (bf16*)(ws + WS_MIX);
    float* SS0 = (float*)(ws + WS_SS0); float* SS1 = (float*)(ws + WS_SS1); float* SS2 = (float*)(ws + WS_SS2); float* SS3 = (float*)(ws + WS_SS3);
    (void)XB; (void)HB; (void)ZB; (void)MIXB; (void)SS0; (void)SS1; (void)SS2; (void)SS3;
        pg8::Gemm g{HB, (const bf16*)(ws + WS_W2D), MP, DM, DFF}; pg8::StaticOrder S; S.init(MP, DM, F.G, (int)blockIdx.x);
        pg8::EpiResid<true, true, false, false> E{nullptr, nullptr, outp + O_Y, XB, SS3, nullptr, 0.5f};
        pg8::gemm_phase<pg8::EpiResid<true, true, false, false>, pg8::StaticOrder, true, true>(F.lds + RING_OFF, g, S, E);
        sgk_resid<true, true, false>(F, HB, DFF, (const bf16*)(ws + WS_W2D), nullptr, XB, outp + O_Y, SS3, 0.5f);
}
__device__ __forceinline__ void phase_9(Frame& F, const In& in, unsigned char* ws, float* outp) {
    bf16* XB = (bf16*)(ws + WS_XB); bf16* HB = (bf16*)(ws + WS_H); bf16* ZB = (bf16*)(ws + WS_Z); bf16* MIXB = (bf16*)(ws + WS_MIX);
    float* SS0 = (float*)(ws + WS_SS0); float* SS1 = (float*)(ws + WS_SS1); float* SS2 = (float*)(ws + WS_SS2); float* SS3 = (float*)(ws + WS_SS3);
    (void)XB; (void)HB; (void)ZB; (void)MIXB; (void)SS0; (void)SS1; (void)SS2; (void)SS3;
        const int gw = F.vcu * NWAVES + F.wave, NGW = F.G * NWAVES;
        const GAS f32x4* lnf = (const GAS f32x4*)in.p[24] + F.lane;
        f32x4 gn[4];
#pragma unroll
        for (int j = 0; j < 4; ++j) gn[j] = lnf[64 * j];
        for (int m0 = gw; m0 < MROWS; m0 += 4 * NGW) {
            f32x4 v[4][4]; float rs[4];
#pragma unroll
            for (int r = 0; r < 4; ++r) {
                const int m = (m0 + r * NGW < MROWS) ? m0 + r * NGW : m0;
                rs[r] = pg8::row_rs16(SS3, m);
                const GAS f32x4* yr = (const GAS f32x4*)(outp + O_Y + (size_t)m * DM) + F.lane;
#pragma unroll
                for (int j = 0; j < 4; ++j) v[r][j] = yr[64 * j];
            }
#pragma unroll
            for (int r = 0; r < 4; ++r) {
                const int m = m0 + r * NGW;
                if (m < MROWS) {
                    GAS f32x4* yr = (GAS f32x4*)(outp + O_Y + (size_t)m * DM) + F.lane;
#pragma unroll
                    for (int j = 0; j < 4; ++j) yr[64 * j] = v[r][j] * rs[r] * gn[j];
                }
            }
        }
}
struct Args { In in; float* out; unsigned char* ws; int ph_lo, ph_hi; };
constexpr int N_PHASES = 10;
#ifndef DUP_PHASE
#define DUP_PHASE (-1)
#endif
__global__ void __launch_bounds__(NWAVES * 64, 2) mega_fwd(Args args) {
    extern __shared__ __attribute__((aligned(16))) unsigned char lds[];
    Frame F;
    F.lds = (LAS unsigned char*)lds;
    F.MISC = (volatile LAS unsigned*)(F.lds + MISC_OFF);
    F.tid = threadIdx.x; F.lane = F.tid & 63; F.wave = __builtin_amdgcn_readfirstlane(F.tid >> 6);
    F.G = gridDim.x; { const int bx = blockIdx.x; F.vcu = (F.G % 8 == 0) ? (bx % 8) * (F.G / 8) + bx / 8 : bx; }
    unsigned char* ws = args.ws; float* outp = args.out; const In& in = args.in;
    F.ctl = (gu32*)(ws + WS_CTL);
    for (int u = F.tid; u < (LDS_BYTES - LDSCTL_OFF) / 4; u += NWAVES * 64) ((LAS unsigned*)(F.lds + LDSCTL_OFF))[u] = 0u;
    __syncthreads();
    const int lo = args.ph_lo, hi = args.ph_hi;
    const bool use_bar = (hi - lo) > 1;
    XcdBarrier bar; bar.bar = (unsigned*)(F.ctl + CW_BAR); bar.x = 0; bar.st = nullptr;
    if (use_bar) bar = xcd_barrier_post((unsigned*)(F.ctl + CW_BAR), F.MISC + 8);
#define IN(k) (lo <= (k) && (k) < hi)
#define SEAM(k) do { if (IN(k) && IN((k) + 1)) xcd_barrier(bar); } while (0)
#define RUN(k) do { if (IN(k)) { phase_##k(F, in, ws, outp); if (DUP_PHASE == (k)) { xcd_barrier(bar); phase_##k(F, in, ws, outp); } } } while (0)
    RUN(0); SEAM(0);
    RUN(1); SEAM(1);
    RUN(2); SEAM(2);
    RUN(3); SEAM(3);
    RUN(4); SEAM(4);
    RUN(5); SEAM(5);
    RUN(6); SEAM(6);
    RUN(7); SEAM(7);
    RUN(8); SEAM(8);
    RUN(9);
#undef IN
#undef SEAM
#undef RUN
}

#ifndef MK_N_LAUNCHES
#define MK_N_LAUNCHES 1
#endif
extern "C" void kernel_launch(void* const* d_in, const int* in_sizes, int n_in, void* d_out, int out_size, void* d_ws, size_t ws_size, hipStream_t stream) {
    static int grid = 0;
    if (grid == 0) {
        if (n_in != 25 || in_sizes[0] != MP * DM || (size_t)out_size != O_END || ws_size < WS_END) { fprintf(stderr, "kernel_launch: unexpected shapes: n_in %d in0 %d out %d ws %zu\n", n_in, n_in > 0 ? in_sizes[0] : -1, out_size, ws_size); grid = -1; return; }
        int dev = 0, cus = 0, per_cu = 0;
        if (hipGetDevice(&dev) != hipSuccess || hipDeviceGetAttribute(&cus, hipDeviceAttributeMultiprocessorCount, dev) != hipSuccess) { grid = -1; return; }
        if (hipFuncSetAttribute((const void*)mega_fwd, hipFuncAttributeMaxDynamicSharedMemorySize, LDS_BYTES) != hipSuccess) { fprintf(stderr, "kernel_launch: hipFuncSetAttribute failed\n"); grid = -1; return; }
        if (hipOccupancyMaxActiveBlocksPerMultiprocessor(&per_cu, (const void*)mega_fwd, NWAVES * 64, LDS_BYTES) != hipSuccess || per_cu < 1) { fprintf(stderr, "kernel_launch: occupancy query says %d\n", per_cu); }
        (void)hipGetLastError();
        grid = cus;
    }
    if (grid < 0) return;
    if (hipMemsetAsync((char*)d_ws + WS_CTL, 0, CTL_ZERO_BYTES, stream) != hipSuccess) return;
    Args a{};
    for (int i = 0; i < 25; ++i) a.in.p[i] = (const float*)d_in[i];
    a.out = (float*)d_out; a.ws = (unsigned char*)d_ws;
#if MK_N_LAUNCHES == 1
    a.ph_lo = 0; a.ph_hi = N_PHASES;
    hipLaunchKernelGGL(mega_fwd, dim3(grid), dim3(NWAVES * 64), LDS_BYTES, stream, a);
#else
    for (int k = 0; k < N_PHASES; ++k) { a.ph_lo = k; a.ph_hi = k + 1; hipLaunchKernelGGL(mega_fwd, dim3(grid), dim3(NWAVES * 64), LDS_BYTES, stream, a); }
#endif
}
```
